# Optimizing an MI355X kernel written in HIP

```python
import math
import jax, jax.numpy as jnp
from jax import lax
import numpy as np

D_MODEL = 1024
BATCH = 2
SEQ = 8192
DEPTH = 1

N_HEADS = 8
HEAD_DIM = 128
ATTN_WIDTH = N_HEADS * HEAD_DIM
MOBA_BLOCK = 256
MOBA_TOPK = 3
Q_CHUNK = 64
ROPE_THETA = 500000.0
ROPE_DIM = HEAD_DIM // 4
CONV_WIDTH = D_MODEL
CONV_K = 3
D_FF = ((8 * D_MODEL // 3 + 255) // 256) * 256
EPS = 1e-6
NEG = -1e30

SPLIT_WIDTHS = [ATTN_WIDTH, ATTN_WIDTH, ATTN_WIDTH,
                CONV_WIDTH, CONV_WIDTH, CONV_WIDTH,
                D_MODEL, D_MODEL]
IN_WIDTH = int(sum(SPLIT_WIDTHS))
SPLIT_IDX = [int(i) for i in np.cumsum(SPLIT_WIDTHS)[:-1]]

kernel_name = "hybrid_moba_shortconv_gated_block"


def rmsnorm(x, g):
    xf = x.astype(jnp.float32)
    y = xf * lax.rsqrt(jnp.mean(xf * xf, axis=-1, keepdims=True) + EPS)
    return (y * g.astype(jnp.float32)).astype(x.dtype)


def partial_rope(t, positions):
    rot, rest = t[..., :ROPE_DIM], t[..., ROPE_DIM:]
    inv_freq = ROPE_THETA ** (-jnp.arange(0, ROPE_DIM, 2, dtype=jnp.float32) / ROPE_DIM)
    ang = positions.astype(jnp.float32)[:, None] * inv_freq[None, :]
    cos, sin = jnp.cos(ang), jnp.sin(ang)
    r = rot.astype(jnp.float32)
    r1, r2 = r[..., : ROPE_DIM // 2], r[..., ROPE_DIM // 2:]
    out = jnp.concatenate([r1 * cos - r2 * sin, r2 * cos + r1 * sin], axis=-1)
    return jnp.concatenate([out.astype(t.dtype), rest], axis=-1)


def moba_attention(q, k, v):
    B, H, S, Dh = q.shape
    S_pad = -(-S // MOBA_BLOCK) * MOBA_BLOCK
    pad = [(0, 0), (0, 0), (0, S_pad - S), (0, 0)]
    q_p, k_p, v_p = jnp.pad(q, pad), jnp.pad(k, pad), jnp.pad(v, pad)
    NB = S_pad // MOBA_BLOCK
    NC = S_pad // Q_CHUNK
    topk = min(MOBA_TOPK, NB)
    scale = 1.0 / math.sqrt(Dh)
    kb = k_p.reshape(B, H, NB, MOBA_BLOCK, Dh)
    vb = v_p.reshape(B, H, NB, MOBA_BLOCK, Dh)
    kmean = kb.astype(jnp.float32).mean(axis=3)
    bi = jnp.arange(B)[:, None, None, None]
    hi = jnp.arange(H)[None, :, None, None]
    q_chunks = q_p.reshape(B, H, NC, Q_CHUNK, Dh).transpose(2, 0, 1, 3, 4)

    def step(args):
        c, qc = args
        q0 = c * Q_CHUNK
        blk = q0 // MOBA_BLOCK
        gate = jnp.einsum('bhqd,bhnd->bhqn', qc.astype(jnp.float32), kmean)
        gate = jnp.where(jnp.arange(NB) < blk, gate, NEG)
        _, idx = lax.top_k(gate, topk)
        valid = jnp.arange(topk) < blk
        kg = kb[bi, hi, idx]
        vg = vb[bi, hi, idx]
        s_past = jnp.einsum('bhqd,bhqjkd->bhqjk', qc, kg).astype(jnp.float32) * scale
        s_past = jnp.where(valid[:, None], s_past, NEG)
        k_own = lax.dynamic_slice_in_dim(k_p, blk * MOBA_BLOCK, MOBA_BLOCK, axis=2)
        v_own = lax.dynamic_slice_in_dim(v_p, blk * MOBA_BLOCK, MOBA_BLOCK, axis=2)
        s_own = jnp.einsum('bhqd,bhkd->bhqk', qc, k_own).astype(jnp.float32) * scale
        causal = (q0 + jnp.arange(Q_CHUNK))[:, None] >= (blk * MOBA_BLOCK + jnp.arange(MOBA_BLOCK))[None, :]
        s_own = jnp.where(causal, s_own, NEG)
        logits = jnp.concatenate([s_past.reshape(B, H, Q_CHUNK, topk * MOBA_BLOCK), s_own], axis=-1)
        p = jax.nn.softmax(logits, axis=-1).astype(v.dtype)
        p_past = p[..., : topk * MOBA_BLOCK].reshape(B, H, Q_CHUNK, topk, MOBA_BLOCK)
        p_own = p[..., topk * MOBA_BLOCK:]
        return (jnp.einsum('bhqjk,bhqjkd->bhqd', p_past, vg)
                + jnp.einsum('bhqk,bhkd->bhqd', p_own, v_own))

    out = lax.map(step, (jnp.arange(NC, dtype=jnp.int32), q_chunks))
    out = out.transpose(1, 2, 0, 3, 4).reshape(B, H, S_pad, Dh)
    return out[:, :, :S]


def causal_depthwise_conv(z, w):
    C = z.shape[-1]
    return lax.conv_general_dilated(
        z, w[:, None, :].astype(z.dtype), window_strides=(1,),
        padding=[(CONV_K - 1, 0)], dimension_numbers=('NWC', 'WIO', 'NWC'),
        feature_group_count=C)


def setup_inputs(seed: int = 0) -> dict:
    key = jax.random.key(seed)
    ks = jax.random.split(key, 12)
    f32 = jnp.float32
    def nrm(k, shape, fan_in):
        return jax.random.normal(k, shape, f32) * (fan_in ** -0.5)
    def gain(k, n):
        return 1.0 + 0.05 * jax.random.normal(k, (DEPTH, n), f32)
    return {
        "x": jax.random.normal(ks[0], (BATCH, SEQ, D_MODEL), f32),
        "g_mix": gain(ks[1], D_MODEL),
        "w_in": nrm(ks[2], (DEPTH, D_MODEL, IN_WIDTH), D_MODEL),
        "conv_w": nrm(ks[3], (DEPTH, CONV_K, CONV_WIDTH), CONV_K),
        "w_attn_branch": nrm(ks[4], (DEPTH, ATTN_WIDTH, D_MODEL), ATTN_WIDTH),
        "w_conv_branch": nrm(ks[5], (DEPTH, CONV_WIDTH, D_MODEL), CONV_WIDTH),
        "w_out": nrm(ks[6], (DEPTH, D_MODEL, D_MODEL), D_MODEL),
        "g_ffn": gain(ks[7], D_MODEL),
        "w_gate_up": nrm(ks[8], (DEPTH, D_MODEL, 2 * D_FF), D_MODEL),
        "w_down": nrm(ks[9], (DEPTH, D_FF, D_MODEL), D_FF),
        "g_final": 1.0 + 0.05 * jax.random.normal(ks[10], (D_MODEL,), f32),
    }


def reference(x, g_mix, w_in, conv_w, w_attn_branch, w_conv_branch, w_out,
              g_ffn, w_gate_up, w_down, g_final):
    B, S, _ = x.shape
    positions = jnp.arange(S, dtype=jnp.int32)
    h = x
    for l in range(DEPTH):
        u = rmsnorm(h, g_mix[l])
        proj = u @ w_in[l]
        q, k, v, c_gate, b_gate, xc, ga, gc = jnp.split(proj, SPLIT_IDX, axis=-1)
        to_heads = lambda t: t.reshape(B, S, N_HEADS, HEAD_DIM).transpose(0, 2, 1, 3)
        qh = partial_rope(to_heads(q), positions)
        kh = partial_rope(to_heads(k), positions)
        vh = to_heads(v)
        attn = moba_attention(qh, kh, vh).transpose(0, 2, 1, 3).reshape(B, S, ATTN_WIDTH)
        y_attn = attn @ w_attn_branch[l]
        zc = causal_depthwise_conv(c_gate * xc, conv_w[l])
        y_conv = (b_gate * zc) @ w_conv_branch[l]
        merged = jax.nn.sigmoid(ga) * y_attn + jax.nn.sigmoid(gc) * y_conv
        h = h + merged @ w_out[l]
        u2 = rmsnorm(h, g_ffn[l])
        gate, up = jnp.split(u2 @ w_gate_up[l], 2, axis=-1)
        h = h + (jax.nn.silu(gate) * up) @ w_down[l]
    return rmsnorm(h, g_final)
```

```cpp
#include <hip/hip_runtime.h>
#include <hip/hip_cooperative_groups.h>
#include <cstdio>
#include <cstdint>
namespace cg = cooperative_groups;

#define LAS __attribute__((address_space(3)))
typedef unsigned short bf16_t;
typedef short bf16x8 __attribute__((ext_vector_type(8)));
typedef short s16x4 __attribute__((ext_vector_type(4)));
typedef float f32x2 __attribute__((ext_vector_type(2)));
typedef float f32x4 __attribute__((ext_vector_type(4)));
typedef float f32x16 __attribute__((ext_vector_type(16)));
typedef unsigned u32x2 __attribute__((ext_vector_type(2)));
typedef unsigned u32x4 __attribute__((ext_vector_type(4)));

constexpr int BATCH = 2, SEQ = 8192, DM = 1024, MTOK = BATCH * SEQ, NHEAD = 8, HD = 128, NKB = SEQ / 256, DFF = 2816, INW = 8192;
constexpr float EPS = 1e-6f;
constexpr float QSCALE = 0.08838834764831845f * 1.4426950408889634f;

__device__ __forceinline__ unsigned cvt_pk_bf16(float lo, float hi) { unsigned r; asm volatile("v_cvt_pk_bf16_f32 %0, %1, %2" : "=v"(r) : "v"(lo), "v"(hi)); return r; }
__device__ __forceinline__ u32x4 pack8u(f32x4 a, f32x4 b) { u32x4 w; w.x = cvt_pk_bf16(a[0], a[1]); w.y = cvt_pk_bf16(a[2], a[3]); w.z = cvt_pk_bf16(b[0], b[1]); w.w = cvt_pk_bf16(b[2], b[3]); return w; }
__device__ __forceinline__ float bf_lo(unsigned w) { return __uint_as_float(w << 16); }
__device__ __forceinline__ float bf_hi(unsigned w) { return __uint_as_float(w & 0xffff0000u); }
__device__ __forceinline__ void unpack8(u32x4 w, f32x4& a, f32x4& b) { a = (f32x4){bf_lo(w.x), bf_hi(w.x), bf_lo(w.y), bf_hi(w.y)}; b = (f32x4){bf_lo(w.z), bf_hi(w.z), bf_lo(w.w), bf_hi(w.w)}; }
__device__ __forceinline__ float sigmoidf_(float x) { return 1.0f / (1.0f + __expf(-x)); }

namespace pg8 {
constexpr int BM = 256, BK = 64, HALF = 128, HTB = HALF * BK * 2, STAGE_BYTES = 8 * HTB, NXCD = 8, WGM = 8;
__host__ __device__ __forceinline__ int lds_byte(int r, int c) { const int st = (r >> 4) * 2 + (c >> 5), rr = r & 15, cc = c & 31, ob = rr * 64 + cc * 2; return st * 1024 + (ob ^ (((ob >> 9) & 1) << 5)); }
__host__ __device__ __forceinline__ void stage_rc(int b, int& R, int& C) { const int st = b / 1024, sb = b % 1024, swz = sb ^ (((sb >> 9) & 1) << 5); R = (st >> 1) * 16 + swz / 64; C = (st & 1) * 32 + (swz % 64) / 2; }
__host__ __device__ __forceinline__ int perm32(int rho) { const int n = rho >> 4, i = rho & 15; return 8 * (i >> 2) + 4 * n + (i & 3); }

struct Unit { int pm, pn; };
struct Gemm { const bf16_t* A; const bf16_t* A2; int pmsplit; const bf16_t* Bt; int M, N, K; };

struct StaticOrder {
    int nM, nN, nwg, G, c;
    __host__ __device__ void init(int M, int N, int G_, int c_) { nM = M / BM; nN = N / BM; nwg = nM * nN; G = G_; c = c_; }
    __host__ __device__ bool next(int i, Unit& u) const {
        const long L = (long)i * G + c; if (L >= nwg) return false;
        int wgid = (int)L; { const int q = nwg / NXCD, r = nwg % NXCD, xcd = wgid % NXCD, off = wgid / NXCD; wgid = (xcd < r ? xcd * (q + 1) : r * (q + 1) + (xcd - r) * q) + off; }
        const int nig = WGM * nN, gid = wgid / nig, fm = gid * WGM, gsz = (nM - fm) < WGM ? (nM - fm) : WGM;
        u.pm = fm + ((wgid % nig) % gsz); u.pn = (wgid % nig) / gsz; return true;
    }
    __device__ __forceinline__ void a_ready(const Unit&) const {}
    __device__ __forceinline__ void done(const Unit&) const {}
};
struct BranchOrder {
    StaticOrder s;
    __device__ bool next(int i, Unit& u) const { if (!s.next(i >> 1, u)) return false; if (i & 1) { u.pm += 64; u.pn += 4; } return true; }
    __device__ __forceinline__ void a_ready(const Unit&) const {}
    __device__ __forceinline__ void done(const Unit&) const {}
};

template <class Epi, class Sched, bool ALIGN_EPI = false, bool SP2 = false>
__device__ __forceinline__ void gemm_phase(LAS unsigned char* lds, const Gemm g, const Sched& S, const Epi& E) {
    int tid = threadIdx.x; asm volatile("" : "+v"(tid));
    const int wid = __builtin_amdgcn_readfirstlane(tid >> 6), lane = tid & 63, wr = wid >> 2, wc = wid & 3, fr = lane & 15, fq = lane >> 4;
    const int K = g.K, nt = K / BK;
    unsigned voffA[2], voffB[2];
#pragma unroll
    for (int i = 0; i < 2; ++i) { int R, C; stage_rc(tid * 16 + i * 8192, R, C); const int Rb = Epi::PERM ? ((R & ~31) + perm32(R & 31)) : R;
        voffA[i] = (unsigned)(R * K + C) * 2u; voffB[i] = (unsigned)(Rb * K + C) * 2u; }
    const size_t kstep = (size_t)(BK * 2);
    const size_t hstep = (size_t)HALF * K * 2;
    const size_t tstep = 2 * hstep;
    const unsigned ldsw = (unsigned)wid * 1024u;
    const int aoff = lds_byte(wr * 64 + fr, fq * 8), boff = lds_byte(wc * 32 + fr, fq * 8);
#define PG8_APTR(pm_) ((pm_) < g.pmsplit ? (const char*)g.A + (size_t)(pm_) * tstep : (const char*)g.A2 + (size_t)((pm_) - g.pmsplit) * tstep)
#define PG8_SA(b, h) (((b) * 2 + (h)) * HTB)
#define PG8_SB(b, h) ((4 + (b) * 2 + (h)) * HTB)
#define PG8_STAGE(bufoff, gbase, voff) do { _Pragma("unroll") for (int _i = 0; _i < 2; ++_i) \
        __builtin_amdgcn_global_load_lds((const unsigned*)((const char*)(gbase) + (voff)[_i]), (LAS unsigned*)(lds + (bufoff) + ldsw + _i * 8192), 16, 0, 0); } while (0)
#define PG8_LDA(dst, b, h) do { _Pragma("unroll") for (int m = 0; m < 4; ++m) _Pragma("unroll") for (int k = 0; k < 2; ++k) dst[m][k] = *(const LAS bf16x8*)(lds + PG8_SA(b, h) + aoff + m * 2048 + k * 1024); } while (0)
#define PG8_LDB(dst, b, h) do { _Pragma("unroll") for (int n = 0; n < 2; ++n) _Pragma("unroll") for (int k = 0; k < 2; ++k) dst[n][k] = *(const LAS bf16x8*)(lds + PG8_SB(b, h) + boff + n * 2048 + k * 1024); } while (0)
#define PG8_MMA(ai, bj, At, Bt) do { __builtin_amdgcn_s_setprio(1); _Pragma("unroll") for (int m = 0; m < 4; ++m) _Pragma("unroll") for (int n = 0; n < 2; ++n) _Pragma("unroll") for (int k = 0; k < 2; ++k) \
        acc[ai][bj][m][n] = __builtin_amdgcn_mfma_f32_16x16x32_bf16(Bt[n][k], At[m][k], acc[ai][bj][m][n], 0, 0, 0); __builtin_amdgcn_s_setprio(0); } while (0)
#define PG8_WAIT_V(n) asm volatile("s_waitcnt vmcnt(" #n ")" ::: "memory")
#define PG8_WAIT_L(n) asm volatile("s_waitcnt lgkmcnt(" #n ")" ::: "memory")
#define PG8_BAR __builtin_amdgcn_s_barrier()
#define PG8_SCHED __builtin_amdgcn_sched_barrier(0)
    Unit cur, nxt; int ui = 0;
    if (!S.next(0, cur)) return;
    f32x4 acc[2][2][4][2];
#pragma unroll
    for (int a = 0; a < 2; ++a)
#pragma unroll
        for (int b = 0; b < 2; ++b)
#pragma unroll
            for (int m = 0; m < 4; ++m)
#pragma unroll
                for (int n = 0; n < 2; ++n) acc[a][b][m][n] = (f32x4){0.f, 0.f, 0.f, 0.f};
    bf16x8 At[4][2], B0[2][2], B1[2][2];
    const char* cA = PG8_APTR(cur.pm); const char* cB = (const char*)g.Bt + (size_t)cur.pn * tstep;
    S.a_ready(cur);
    if constexpr (SP2) {
        PG8_STAGE(PG8_SB(0, 0), cB, voffB); PG8_STAGE(PG8_SB(0, 1), cB + hstep, voffB); PG8_STAGE(PG8_SA(0, 0), cA, voffA); PG8_STAGE(PG8_SA(0, 1), cA + hstep, voffA);
        if (wr == 1) PG8_BAR;
        PG8_WAIT_V(2); PG8_BAR;
        PG8_STAGE(PG8_SB(1, 0), cB + kstep, voffB); PG8_STAGE(PG8_SA(1, 0), cA + kstep, voffA); PG8_STAGE(PG8_SB(1, 1), cB + hstep + kstep, voffB);
        PG8_WAIT_V(6); PG8_BAR;
    } else {
        PG8_STAGE(PG8_SB(0, 0), cB, voffB); PG8_STAGE(PG8_SA(0, 0), cA, voffA); PG8_STAGE(PG8_SB(0, 1), cB + hstep, voffB); PG8_STAGE(PG8_SA(0, 1), cA + hstep, voffA);
        if (wr == 1) PG8_BAR;
        PG8_WAIT_V(4); PG8_BAR;
        PG8_STAGE(PG8_SB(1, 0), cB + kstep, voffB); PG8_STAGE(PG8_SA(1, 0), cA + kstep, voffA); PG8_STAGE(PG8_SB(1, 1), cB + hstep + kstep, voffB);
        PG8_WAIT_V(6); PG8_BAR;
    }
    for (;;) {
        const bool has_next = S.next(ui + 1, nxt);
        const char* nA = has_next ? PG8_APTR(nxt.pm) : cA; const char* nB = has_next ? (const char*)g.Bt + (size_t)nxt.pn * tstep : cB;
        for (int t = 0; t < nt; t += 2) {
            const bool last = (t == nt - 2);
            const char* a1 = cA + (size_t)(t + 1) * kstep;
            const char* a2 = last ? nA : cA + (size_t)(t + 2) * kstep; const char* b2 = last ? nB : cB + (size_t)(t + 2) * kstep;
            const char* a3 = a2 + kstep; const char* b3 = b2 + kstep;
            if (last && has_next) S.a_ready(nxt);
            if constexpr (SP2) {
            PG8_LDB(B0, 0, 0); PG8_LDB(B1, 0, 1); PG8_SCHED; PG8_LDA(At, 0, 0); PG8_STAGE(PG8_SA(1, 1), a1 + hstep, voffA);
            PG8_WAIT_V(8); PG8_WAIT_L(0); PG8_BAR; PG8_MMA(0, 0, At, B0); PG8_MMA(0, 1, At, B1); PG8_BAR; PG8_SCHED;
            PG8_LDA(At, 0, 1); PG8_STAGE(PG8_SB(0, 0), b2, voffB); PG8_STAGE(PG8_SB(0, 1), b2 + hstep, voffB); PG8_STAGE(PG8_SA(0, 0), a2, voffA);
            PG8_WAIT_V(8); PG8_WAIT_L(0); PG8_BAR; PG8_MMA(1, 0, At, B0); PG8_MMA(1, 1, At, B1); PG8_BAR; PG8_SCHED;
            PG8_LDB(B0, 1, 0); PG8_LDB(B1, 1, 1); PG8_SCHED; PG8_LDA(At, 1, 0); PG8_STAGE(PG8_SA(0, 1), a2 + hstep, voffA);
            PG8_WAIT_V(8); PG8_WAIT_L(0); PG8_BAR; PG8_MMA(0, 0, At, B0); PG8_MMA(0, 1, At, B1); PG8_BAR; PG8_SCHED;
            PG8_LDA(At, 1, 1); PG8_STAGE(PG8_SB(1, 0), b3, voffB); PG8_STAGE(PG8_SB(1, 1), b3 + hstep, voffB); PG8_STAGE(PG8_SA(1, 0), a3, voffA);
            PG8_WAIT_V(8); PG8_WAIT_L(0); PG8_BAR; PG8_MMA(1, 0, At, B0); PG8_MMA(1, 1, At, B1); PG8_BAR; PG8_SCHED;
            } else {
            PG8_LDB(B0, 0, 0); PG8_SCHED; PG8_LDA(At, 0, 0); PG8_STAGE(PG8_SA(1, 1), a1 + hstep, voffA);
            PG8_WAIT_L(8); PG8_BAR; PG8_WAIT_L(0); PG8_MMA(0, 0, At, B0); PG8_BAR; PG8_SCHED;
            PG8_LDB(B1, 0, 1); PG8_STAGE(PG8_SB(0, 0), b2, voffB);
            PG8_BAR; PG8_WAIT_L(0); PG8_MMA(0, 1, At, B1); PG8_BAR;
            PG8_LDA(At, 0, 1); PG8_STAGE(PG8_SA(0, 0), a2, voffA);
            PG8_BAR; PG8_WAIT_L(0); PG8_MMA(1, 0, At, B0); PG8_BAR; PG8_SCHED;
            PG8_STAGE(PG8_SB(0, 1), b2 + hstep, voffB);
            PG8_WAIT_V(6); PG8_BAR; PG8_MMA(1, 1, At, B1); PG8_BAR;
            PG8_LDB(B0, 1, 0); PG8_SCHED; PG8_LDA(At, 1, 0); PG8_STAGE(PG8_SA(0, 1), a2 + hstep, voffA);
            PG8_WAIT_L(8); PG8_BAR; PG8_WAIT_L(0); PG8_MMA(0, 0, At, B0); PG8_BAR; PG8_SCHED;
            PG8_LDB(B1, 1, 1); PG8_STAGE(PG8_SB(1, 0), b3, voffB);
            PG8_BAR; PG8_WAIT_L(0); PG8_MMA(0, 1, At, B1); PG8_BAR;
            PG8_LDA(At, 1, 1); PG8_STAGE(PG8_SA(1, 0), a3, voffA);
            PG8_BAR; PG8_WAIT_L(0); PG8_MMA(1, 0, At, B0); PG8_BAR; PG8_SCHED;
            PG8_STAGE(PG8_SB(1, 1), b3 + hstep, voffB);
            PG8_WAIT_V(6); PG8_BAR; PG8_MMA(1, 1, At, B1); PG8_BAR;
            }
        }
        if constexpr (ALIGN_EPI) { if (wr == 0) PG8_BAR; }
        E(acc, cur, wr, wc, fr, fq); S.done(cur);
        if (!has_next) break;
#pragma unroll
        for (int a = 0; a < 2; ++a)
#pragma unroll
            for (int b = 0; b < 2; ++b)
#pragma unroll
                for (int m = 0; m < 4; ++m)
#pragma unroll
                    for (int n = 0; n < 2; ++n) acc[a][b][m][n] = (f32x4){0.f, 0.f, 0.f, 0.f};
        cur = nxt; cA = nA; cB = nB; ++ui;
        if constexpr (ALIGN_EPI) { if (wr == 1) PG8_BAR; }
    }
    PG8_WAIT_V(0);
    if constexpr (!ALIGN_EPI) { if (wr == 0) PG8_BAR; }
    PG8_BAR;
#undef PG8_APTR
#undef PG8_SA
#undef PG8_SB
#undef PG8_STAGE
#undef PG8_LDA
#undef PG8_LDB
#undef PG8_MMA
#undef PG8_WAIT_V
#undef PG8_WAIT_L
#undef PG8_BAR
#undef PG8_SCHED
}

struct EpiIn {
    static constexpr bool PERM = true;
    bf16_t *Q, *K, *V, *P, *BG, *SGA, *SGC; float* KM; const float* RC; const float* RS;
    __device__ __forceinline__ void operator()(const f32x4 (&acc)[2][2][4][2], const Unit& u, int wr, int wc, int fr, int fq) const {
        const int pn = u.pn, row0 = u.pm * BM + wr * 64 + fr, cw = wc * 32 + 8 * fq;
        if (pn < 8) {
            const bool isq = pn < 4; bf16_t* O = (isq ? Q : K) + (pn & 3) * 256 + cw;
            const float sgn = fq < 2 ? -1.f : 1.f;
            float ks[2][2][4];
#pragma unroll
            for (int bj = 0; bj < 2; ++bj)
#pragma unroll
                for (int n = 0; n < 2; ++n)
#pragma unroll
                    for (int e = 0; e < 4; ++e) ks[bj][n][e] = 0.f;
#pragma unroll
            for (int ai = 0; ai < 2; ++ai)
#pragma unroll
                for (int m = 0; m < 4; ++m) {
                    const int row = row0 + ai * HALF + m * 16, pos = row & (SEQ - 1);
                    f32x4 c0 = {1.f, 1.f, 1.f, 1.f}, c1 = c0, s0 = {0.f, 0.f, 0.f, 0.f}, s1 = s0;
                    if (wc == 0) { const float* rc = RC + pos * 16 + 8 * (fq & 1); const float* rs = RS + pos * 16 + 8 * (fq & 1);
                        c0 = *(const f32x4*)rc; c1 = *(const f32x4*)(rc + 4); s0 = *(const f32x4*)rs; s1 = *(const f32x4*)(rs + 4); }
#pragma unroll
                    for (int bj = 0; bj < 2; ++bj) {
                        f32x4 v0 = acc[ai][bj][m][0], v1 = acc[ai][bj][m][1];
                        if (wc == 0) {
                            f32x4 p0, p1;
#pragma unroll
                            for (int e = 0; e < 4; ++e) { p0[e] = __shfl_xor(v0[e], 32); p1[e] = __shfl_xor(v1[e], 32); }
                            v0 = v0 * c0 + (p0 * s0) * sgn; v1 = v1 * c1 + (p1 * s1) * sgn;
                        }
                        if (isq) { v0 = v0 * QSCALE; v1 = v1 * QSCALE; }
                        else {
#pragma unroll
                            for (int e = 0; e < 4; ++e) { ks[bj][0][e] += v0[e]; ks[bj][1][e] += v1[e]; } }
                        *(u32x4*)(O + (size_t)row * DM + bj * HALF) = pack8u(v0, v1);
                    }
                }
            if (!isq) {
                float* kmb = KM + ((size_t)((u.pm >> 5) * NHEAD + 2 * (pn & 3)) * NKB + (u.pm & 31)) * HD + cw;
#pragma unroll
                for (int bj = 0; bj < 2; ++bj)
#pragma unroll
                    for (int n = 0; n < 2; ++n)
#pragma unroll
                        for (int e = 0; e < 4; ++e) { float v = ks[bj][n][e];
                            v += __shfl_xor(v, 1); v += __shfl_xor(v, 2); v += __shfl_xor(v, 4); v += __shfl_xor(v, 8);
                            if (fr == 0) atomicAdd(kmb + (size_t)bj * NKB * HD + 4 * n + e, v); }
            }
        } else if (pn < 12 || (pn >= 20 && pn < 24)) {
            bf16_t* O = (pn < 12 ? V + (pn - 8) * 256 : BG + (pn - 20) * 256) + cw;
#pragma unroll
            for (int ai = 0; ai < 2; ++ai)
#pragma unroll
                for (int m = 0; m < 4; ++m) { const int row = row0 + ai * HALF + m * 16;
#pragma unroll
                    for (int bj = 0; bj < 2; ++bj) *(u32x4*)(O + (size_t)row * DM + bj * HALF) = pack8u(acc[ai][bj][m][0], acc[ai][bj][m][1]); }
        } else if (pn < 20) {
            bf16_t* O = P + (pn - 12) * 128 + cw;
#pragma unroll
            for (int ai = 0; ai < 2; ++ai)
#pragma unroll
                for (int m = 0; m < 4; ++m) { const int row = row0 + ai * HALF + m * 16;
                    *(u32x4*)(O + (size_t)row * DM) = pack8u(acc[ai][0][m][0] * acc[ai][1][m][0], acc[ai][0][m][1] * acc[ai][1][m][1]); }
        } else {
            bf16_t* O = (pn < 28 ? SGA + (pn - 24) * 256 : SGC + (pn - 28) * 256) + cw;
#pragma unroll
            for (int ai = 0; ai < 2; ++ai)
#pragma unroll
                for (int m = 0; m < 4; ++m) { const int row = row0 + ai * HALF + m * 16;
#pragma unroll
                    for (int bj = 0; bj < 2; ++bj) { f32x4 v0 = acc[ai][bj][m][0], v1 = acc[ai][bj][m][1];
#pragma unroll
                        for (int e = 0; e < 4; ++e) { v0[e] = sigmoidf_(v0[e]); v1[e] = sigmoidf_(v1[e]); }
                        *(u32x4*)(O + (size_t)row * DM + bj * HALF) = pack8u(v0, v1); } }
        }
    }
};
struct EpiBranch {
    static constexpr bool PERM = true;
    const bf16_t *SGA, *SGC; float* T; bf16_t* MG;
    __device__ __forceinline__ void operator()(const f32x4 (&acc)[2][2][4][2], const Unit& u, int wr, int wc, int fr, int fq) const {
        const int type = u.pm >> 6, pm = u.pm & 63, pn = u.pn & 3;
        const int row0 = pm * BM + wr * 64 + fr, col0 = pn * BM + wc * 32 + 8 * fq;
        const bf16_t* SG = type ? SGC : SGA;
#pragma unroll
        for (int ai = 0; ai < 2; ++ai)
#pragma unroll
            for (int m = 0; m < 4; ++m) { const size_t ro = (size_t)(row0 + ai * HALF + m * 16) * DM + col0;
#pragma unroll
                for (int bj = 0; bj < 2; ++bj) { const size_t o = ro + bj * HALF;
                    f32x4 g0, g1; unpack8(*(const u32x4*)(SG + o), g0, g1);
                    f32x4 v0 = acc[ai][bj][m][0] * g0, v1 = acc[ai][bj][m][1] * g1;
                    if (type == 0) { *(f32x4*)(T + o) = v0; *(f32x4*)(T + o + 4) = v1; }
                    else { v0 = v0 + *(const f32x4*)(T + o); v1 = v1 + *(const f32x4*)(T + o + 4); *(u32x4*)(MG + o) = pack8u(v0, v1); } } }
    }
};
struct EpiH1 {
    static constexpr bool PERM = false;
    const float* X; float* H1; bf16_t* H1B; float* SSQ;
    __device__ __forceinline__ void operator()(const f32x4 (&acc)[2][2][4][2], const Unit& u, int wr, int wc, int fr, int fq) const {
        const int row0 = u.pm * BM + wr * 64 + fr, col0 = u.pn * BM + wc * 32 + 4 * fq;
#pragma unroll
        for (int ai = 0; ai < 2; ++ai)
#pragma unroll
            for (int m = 0; m < 4; ++m) { const int row = row0 + ai * HALF + m * 16; const size_t ro = (size_t)row * DM + col0; float ss = 0.f;
#pragma unroll
                for (int bj = 0; bj < 2; ++bj)
#pragma unroll
                    for (int n = 0; n < 2; ++n) { const size_t o = ro + bj * HALF + n * 16;
                        const f32x4 h = *(const f32x4*)(X + o) + acc[ai][bj][m][n];
                        *(f32x4*)(H1 + o) = h; u32x2 w; w.x = cvt_pk_bf16(h[0], h[1]); w.y = cvt_pk_bf16(h[2], h[3]); *(u32x2*)(H1B + o) = w;
                        ss += (h[0] * h[0] + h[1] * h[1]) + (h[2] * h[2] + h[3] * h[3]); }
                ss += __shfl_xor(ss, 16); ss += __shfl_xor(ss, 32);
                if (fq == 0) atomicAdd(SSQ + row, ss); }
    }
};
struct EpiSwiglu {
    static constexpr bool PERM = true;
    const float* SSQ; bf16_t* HFF;
    __device__ __forceinline__ void operator()(const f32x4 (&acc)[2][2][4][2], const Unit& u, int wr, int wc, int fr, int fq) const {
        const int row0 = u.pm * BM + wr * 64 + fr, col0 = u.pn * HALF + wc * 32 + 8 * fq;
#pragma unroll
        for (int ai = 0; ai < 2; ++ai)
#pragma unroll
            for (int m = 0; m < 4; ++m) { const int row = row0 + ai * HALF + m * 16;
                const float rstd = 1.0f / sqrtf(SSQ[row] * (1.0f / DM) + EPS);
                f32x4 o[2];
#pragma unroll
                for (int n = 0; n < 2; ++n)
#pragma unroll
                    for (int e = 0; e < 4; ++e) { const float gg = acc[ai][0][m][n][e] * rstd, uu = acc[ai][1][m][n][e] * rstd; o[n][e] = gg * sigmoidf_(gg) * uu; }
                *(u32x4*)(HFF + (size_t)row * DFF + col0) = pack8u(o[0], o[1]); }
    }
};
struct EpiDown {
    static constexpr bool PERM = false;
    float* OUT; float* SSQ;
    __device__ __forceinline__ void operator()(const f32x4 (&acc)[2][2][4][2], const Unit& u, int wr, int wc, int fr, int fq) const {
        const int row0 = u.pm * BM + wr * 64 + fr, col0 = u.pn * BM + wc * 32 + 4 * fq;
#pragma unroll
        for (int ai = 0; ai < 2; ++ai)
#pragma unroll
            for (int m = 0; m < 4; ++m) { const int row = row0 + ai * HALF + m * 16; const size_t ro = (size_t)row * DM + col0; float ss = 0.f;
#pragma unroll
                for (int bj = 0; bj < 2; ++bj)
#pragma unroll
                    for (int n = 0; n < 2; ++n) { const size_t o = ro + bj * HALF + n * 16;
                        const f32x4 h = *(const f32x4*)(OUT + o) + acc[ai][bj][m][n];
                        *(f32x4*)(OUT + o) = h;
                        ss += (h[0] * h[0] + h[1] * h[1]) + (h[2] * h[2] + h[3] * h[3]); }
                ss += __shfl_xor(ss, 16); ss += __shfl_xor(ss, 32);
                if (fq == 0) atomicAdd(SSQ + row, ss); }
    }
};
}

namespace att {
constexpr int NW = 8, QBLK = 32, KVBLK = 64, QB = NW * QBLK, D = 128, RS = DM;
constexpr int SHM_V = KVBLK * D * 2, SHM_K = KVBLK * D * 2;
constexpr int LDS_BYTES = 2 * SHM_V + 2 * SHM_K + NW * 64 * 4;
constexpr float THR = 8.f;
#define KSWZ(row, colB) ((row) * 256 + ((colB) ^ (((row) & 7) << 4)))
#define SBAR() __builtin_amdgcn_sched_barrier(0)
__device__ __forceinline__ int v_st(int k, int c) { const int kk = (k & ~0xC) | ((k & 4) << 1) | ((k & 8) >> 1); return ((kk >> 3) * 4 + (c >> 5)) * 512 + ((kk & 7) * 32 + (c & 31)) * 2; }
__device__ __forceinline__ int v_rd_base(int lane) { return ((lane & 3) << 3) | (((lane >> 2) & 3) << 6) | (((lane >> 4) & 1) << 5) | (((lane >> 5) & 1) << 8); }
constexpr int v_rd_off(int d0, int ks, int half) { return d0 * 512 + ks * 4096 + half * 2048; }
__device__ __forceinline__ int crow(int r, int hi) { return (r & 3) + 8 * (r >> 2) + 4 * hi; }
__device__ __forceinline__ unsigned cvtpk(float lo, float hi) { unsigned r; asm volatile("v_cvt_pk_bf16_f32 %0, %1, %2" : "=v"(r) : "v"(lo), "v"(hi)); return r; }
__device__ __forceinline__ bf16x8 load8(const bf16_t* p) { return *reinterpret_cast<const bf16x8*>(p); }
__device__ __forceinline__ void mask_causal(f32x16& p0, f32x16& p1, int dq) {
    const float NEG = -__builtin_inff();
#pragma unroll
    for (int r = 0; r < 16; ++r) { const int c = (r & 3) + 8 * (r >> 2);
        if (dq - c < 0) p0[r] = NEG;
        if (dq - c - 32 < 0) p1[r] = NEG; }
}
__device__ __forceinline__ void mask_row(f32x16& p0, f32x16& p1, bool keep) {
    const float NEG = -__builtin_inff();
#pragma unroll
    for (int r = 0; r < 16; ++r) { p0[r] = keep ? p0[r] : NEG; p1[r] = keep ? p1[r] : NEG; }
}
__device__ __forceinline__ void partialSM(f32x16& p0, f32x16& p1, float& m_reg, float& mn, float& alpha) {
    float pmax = p0[0];
#pragma unroll
    for (int r = 1; r < 16; ++r) pmax = fmaxf(pmax, p0[r]);
#pragma unroll
    for (int r = 0; r < 16; ++r) pmax = fmaxf(pmax, p1[r]);
    { auto rr = __builtin_amdgcn_permlane32_swap(__float_as_uint(pmax), __float_as_uint(pmax), false, false);
      pmax = fmaxf(__uint_as_float(rr[0]), __uint_as_float(rr[1])); }
    if (__builtin_expect(__all((pmax - m_reg) <= THR), 1)) { mn = m_reg; alpha = 1.f; }
    else { mn = fmaxf(m_reg, pmax); alpha = __builtin_amdgcn_exp2f(m_reg - mn); m_reg = mn; }
#pragma unroll
    for (int r = 0; r < 16; ++r) p0[r] = p0[r] - mn;
#pragma unroll
    for (int r = 0; r < 16; ++r) p1[r] = p1[r] - mn;
#pragma unroll
    for (int r = 0; r < 16; ++r) p0[r] = __builtin_amdgcn_exp2f(p0[r]);
}
__device__ __forceinline__ void finishSM(f32x16& p0, f32x16& p1, float alpha, float& l_reg, bf16x8& pa0, bf16x8& pa1, bf16x8& pa2, bf16x8& pa3) {
#pragma unroll
    for (int r = 0; r < 16; ++r) p1[r] = __builtin_amdgcn_exp2f(p1[r]);
    float ps = 0;
#pragma unroll
    for (int r = 0; r < 16; ++r) ps += p0[r];
#pragma unroll
    for (int r = 0; r < 16; ++r) ps += p1[r];
    { auto rr = __builtin_amdgcn_permlane32_swap(__float_as_uint(ps), __float_as_uint(ps), false, false);
      ps = __uint_as_float(rr[0]) + __uint_as_float(rr[1]); }
    l_reg = l_reg * alpha + ps;
#define PK4(P, B_, OUT) do { unsigned a0 = cvtpk(P[B_+0], P[B_+1]), a1 = cvtpk(P[B_+2], P[B_+3]);                          \
        unsigned b0 = cvtpk(P[B_+4], P[B_+5]), b1 = cvtpk(P[B_+6], P[B_+7]);                                             \
        auto r0 = __builtin_amdgcn_permlane32_swap(a0, b0, false, false); auto r1 = __builtin_amdgcn_permlane32_swap(a1, b1, false, false); \
        u32x4 w = {r0[0], r1[0], r0[1], r1[1]}; OUT = *reinterpret_cast<bf16x8*>(&w); } while (0)
    PK4(p0, 0, pa0); PK4(p0, 8, pa1); PK4(p1, 0, pa2); PK4(p1, 8, pa3);
#undef PK4
}
template <int KB>
__device__ __forceinline__ void qkt(f32x16& p0, f32x16& p1, const char* K_lds, int r32, int hi, const bf16x8* qr, bool act) {
    if (!act) { const float NEG = -__builtin_inff();
#pragma unroll
        for (int r = 0; r < 16; ++r) { p0[r] = NEG; p1[r] = NEG; } return; }
    p0 = f32x16{}; p1 = f32x16{};
    const char* kb[4];
#pragma unroll
    for (int dd = 0; dd < 4; ++dd) kb[dd] = K_lds + KB * SHM_K + KSWZ(r32, (dd * 16 + hi * 8) * 2);
#pragma unroll
    for (int d0 = 0; d0 < 8; ++d0) { const char* a = kb[d0 & 3] + (d0 >> 2) * 128;
        bf16x8 b0 = *reinterpret_cast<const bf16x8*>(a);
        bf16x8 b1 = *reinterpret_cast<const bf16x8*>(a + 32 * 256);
        p0 = __builtin_amdgcn_mfma_f32_32x32x16_bf16(b0, qr[d0], p0, 0, 0, 0);
        p1 = __builtin_amdgcn_mfma_f32_32x32x16_bf16(b1, qr[d0], p1, 0, 0, 0); }
}
template <int VB>
__device__ __forceinline__ void pv_tile(f32x16* o, int vb0, bf16x8 pa0, bf16x8 pa1, bf16x8 pa2, bf16x8 pa3, bool act) {
    if (!act) return;
#define TRRD(dst, off) asm volatile("ds_read_b64_tr_b16 %0, %1 offset:%2" : "=&v"(dst) : "v"(vb0), "i"(off) : "memory")
#define PV_D0(d0) do { s16x4 l0, l1, l2, l3, h0, h1, h2, h3; constexpr int b_ = VB * SHM_V + v_rd_off(d0, 0, 0); \
        TRRD(l0, b_); TRRD(h0, b_ + 2048); TRRD(l1, b_ + 4096); TRRD(h1, b_ + 6144); TRRD(l2, b_ + 8192); TRRD(h2, b_ + 10240); TRRD(l3, b_ + 12288); TRRD(h3, b_ + 14336); \
        asm volatile("s_waitcnt lgkmcnt(0)" ::: "memory"); SBAR();   \
        o[d0] = __builtin_amdgcn_mfma_f32_32x32x16_bf16(pa0, (bf16x8){l0[0], l0[1], l0[2], l0[3], h0[0], h0[1], h0[2], h0[3]}, o[d0], 0, 0, 0);   \
        o[d0] = __builtin_amdgcn_mfma_f32_32x32x16_bf16(pa1, (bf16x8){l1[0], l1[1], l1[2], l1[3], h1[0], h1[1], h1[2], h1[3]}, o[d0], 0, 0, 0);   \
        o[d0] = __builtin_amdgcn_mfma_f32_32x32x16_bf16(pa2, (bf16x8){l2[0], l2[1], l2[2], l2[3], h2[0], h2[1], h2[2], h2[3]}, o[d0], 0, 0, 0);   \
        o[d0] = __builtin_amdgcn_mfma_f32_32x32x16_bf16(pa3, (bf16x8){l3[0], l3[1], l3[2], l3[3], h3[0], h3[1], h3[2], h3[3]}, o[d0], 0, 0, 0); } while (0)
    PV_D0(0); PV_D0(1); PV_D0(2); PV_D0(3);
#undef PV_D0
#undef TRRD
}
struct BlockRef { const bf16_t* Q; const bf16_t* K; const bf16_t* V; bf16_t* O; const float* KM; int qb; };
struct Seam { bf16x8 qr[8]; bf16x8 st_v0, st_v1, st_k0, st_k1; };
#define LD16(base, off) (*reinterpret_cast<const bf16x8*>((const char*)(base) + (off)))
#define VMW() asm volatile("s_waitcnt vmcnt(0)" ::: "memory")
#define VMWN(n) asm volatile("s_waitcnt vmcnt(%0)" :: "i"(n) : "memory")
#define SLOAD_H(Kp, Vp, k0) do { const char* kb_ = (const char*)(Kp) + (size_t)(k0) * (RS * 2); const char* vb_ = (const char*)(Vp) + (size_t)(k0) * (RS * 2); \
                         S.st_v0 = LD16(vb_, lofs); S.st_v1 = LD16(vb_ + 32 * RS * 2, lofs);              \
                         S.st_k0 = LD16(kb_, lofs); S.st_k1 = LD16(kb_ + 32 * RS * 2, lofs); } while (0)
#define SWRITE_HK(bf) do { *(bf16x8*)(K_lds + (bf) * SHM_K + kws) = S.st_k0; *(bf16x8*)(K_lds + (bf) * SHM_K + kws + 32 * 256) = S.st_k1; } while (0)
#define SWRITE_HV(bf) do { *(bf16x8*)(V_lds + (bf) * SHM_V + vst0) = S.st_v0; *(bf16x8*)(V_lds + (bf) * SHM_V + vst1) = S.st_v1; } while (0)
#define SWRITE_H(bf) do { SWRITE_HV(bf); SWRITE_HK(bf); } while (0)
__device__ __forceinline__ void moba_prime(const BlockRef& cur, char* lds, Seam& S) {
    int tid = threadIdx.x; asm volatile("" : "+v"(tid));
    const int wid = __builtin_amdgcn_readfirstlane(tid >> 6), lane = tid & 63, r32 = lane & 31, hi = lane >> 5;
    const int sr = tid >> 4, sc = (tid & 15) * 8, kws = KSWZ(sr, sc * 2); char* K_lds = lds + 2 * SHM_V;
    const unsigned lofs = (unsigned)(sr * RS + sc) * 2u, qofs = (unsigned)((wid * QBLK + r32) * RS + hi * 8) * 2u;
    { const char* qb_ = (const char*)cur.Q + (size_t)cur.qb * (QB * RS * 2);
#pragma unroll
    for (int d0 = 0; d0 < 8; ++d0) S.qr[d0] = LD16(qb_ + d0 * 32, qofs); }
    SLOAD_H(cur.K, cur.V, 0); VMW(); SWRITE_HK(0);
    __syncthreads();
}
__device__ __forceinline__ void moba_block(const BlockRef& cur, const BlockRef& nxt, char* lds, Seam& S) {
    int tid = threadIdx.x; asm volatile("" : "+v"(tid));
    const int wid = __builtin_amdgcn_readfirstlane(tid >> 6), lane = tid & 63, r32 = lane & 31, hi = lane >> 5;
    const int qb = cur.qb, NT = 4 * (qb + 1);
    const int qrel = wid * QBLK;
    char* V_lds = lds; char* K_lds = lds + 2 * SHM_V;
    float* ws = (float*)(lds + 2 * SHM_V + 2 * SHM_K) + wid * 64; float* li_l = ws, * al_l = ws + 32;
    unsigned sel = 0u;
    {
        f32x16 g = f32x16{};
#pragma unroll
        for (int d0 = 0; d0 < 8; ++d0) {
            const char* kp = (const char*)cur.KM + d0 * 64; const unsigned kofs = (unsigned)(r32 * D + hi * 8) * 4u;
            const f32x4 a = *(const f32x4*)(kp + kofs), b = *(const f32x4*)(kp + 16 + kofs);
            const u32x4 wh = pack8u(a, b); f32x4 ah, bh; unpack8(wh, ah, bh);
            const u32x4 wl = pack8u(a - ah, b - bh);
            g = __builtin_amdgcn_mfma_f32_32x32x16_bf16(*reinterpret_cast<const bf16x8*>(&wh), S.qr[d0], g, 0, 0, 0);
            g = __builtin_amdgcn_mfma_f32_32x32x16_bf16(*reinterpret_cast<const bf16x8*>(&wl), S.qr[d0], g, 0, 0, 0);
        }
        const float NEG = -__builtin_inff();
#pragma unroll
        for (int r = 0; r < 16; ++r) if (crow(r, hi) >= qb) g[r] = NEG;
#pragma unroll
        for (int round = 0; round < 3; ++round) {
            float bv = NEG; int bn = 64;
#pragma unroll
            for (int r = 0; r < 16; ++r) if (g[r] > bv) { bv = g[r]; bn = crow(r, hi); }
            const float ov = __shfl_xor(bv, 32); const int on = __shfl_xor(bn, 32);
            if (ov > bv || (ov == bv && on < bn)) { bv = ov; bn = on; }
            if (bv > NEG) sel |= 1u << bn;
#pragma unroll
            for (int r = 0; r < 16; ++r) if (crow(r, hi) == bn) g[r] = NEG;
        }
    }
    float m_reg = -1e30f, l_reg = 0; f32x16 o[4] = {};
    const int sr = tid >> 4, sc = (tid & 15) * 8, vst0 = v_st(sr, sc), vst1 = v_st(32 + sr, sc), kws = KSWZ(sr, sc * 2);
    const unsigned lofs = (unsigned)(sr * RS + sc) * 2u;
    const int vb0 = (int)(uintptr_t)V_lds + v_rd_base(lane);
    const bf16_t* Kh = cur.K; const bf16_t* Vh = cur.V;
#define RESC(a) do { if (__any((a) < 1.f)) { if (hi == 0) al_l[r32] = (a); asm volatile("s_waitcnt lgkmcnt(0)" ::: "memory");              \
                     for (int d_ = 0; d_ < 4; ++d_) for (int r = 0; r < 16; ++r) o[d_][r] *= al_l[crow(r, hi)]; } } while (0)
#define KBASE(t) ((t) * KVBLK)
#define ACT(t) ((((t) >> 2) < qb) ? (__any((int)((sel >> ((t) >> 2)) & 1u)) != 0) : ((((t) & 3) * KVBLK) <= qrel + QBLK - 1))
#define MASKT(P0_, P1_, t) do { const int n_ = (t) >> 2; if (n_ < qb) { const bool keep_ = ((sel >> n_) & 1u) != 0u; if (!__all((int)keep_)) mask_row(P0_, P1_, keep_); } \
        else { const int kbl_ = ((t) & 3) * KVBLK; if (kbl_ + KVBLK - 1 > qrel) mask_causal(P0_, P1_, qrel + r32 - 4 * hi - kbl_); } } while (0)
    constexpr int NQL = 8;
#define SEAM_K0() do { VMWN(NQL); SWRITE_HK(0); SBAR(); } while (0)
    f32x16 pA0, pA1, pB0, pB1; float mnA, mnB, alA, alB; bf16x8 pa0, pa1, pa2, pa3;
    SWRITE_HV(0); SBAR();
    if (NT > 1) { SLOAD_H(Kh, Vh, KBASE(1)); }
    SBAR(); qkt<0>(pA0, pA1, K_lds, r32, hi, S.qr, ACT(0));
    MASKT(pA0, pA1, 0); partialSM(pA0, pA1, m_reg, mnA, alA);
    if (NT > 1) { VMW(); SWRITE_H(1); }
    __syncthreads();
#define HALF_STEP(PX0, PX1, mnX, alX, PY0, PY1, alY, t, KB, VB, SB) do {                                                      \
        SBAR(); qkt<KB>(PX0, PX1, K_lds, r32, hi, S.qr, ACT(t));                                             \
        finishSM(PY0, PY1, alY, l_reg, pa0, pa1, pa2, pa3); SBAR();                                                           \
        if ((t) + 1 < NT) { SLOAD_H(Kh, Vh, KBASE((t) + 1)); SBAR(); }                                               \
        pv_tile<VB>(o, vb0, pa0, pa1, pa2, pa3, ACT((t) - 1)); MASKT(PX0, PX1, (t)); partialSM(PX0, PX1, m_reg, mnX, alX);                                        \
        __syncthreads();                                                                                                      \
        if ((t) + 1 < NT) { VMW(); SWRITE_H(SB); }                                                                          \
        RESC(alX); __syncthreads(); } while (0)
    for (int t = 1; t + 1 < NT; t += 2) {
        HALF_STEP(pB0, pB1, mnB, alB, pA0, pA1, alA, t, 1, 0, 0);
        HALF_STEP(pA0, pA1, mnA, alA, pB0, pB1, alB, t + 1, 0, 1, 1);
    }
    SBAR(); qkt<1>(pB0, pB1, K_lds, r32, hi, S.qr, ACT(NT - 1)); SBAR();
    SLOAD_H(nxt.K, nxt.V, 0); SBAR();
    { const char* qb_ = (const char*)nxt.Q + (size_t)nxt.qb * (QB * RS * 2); const unsigned qofs = (unsigned)((wid * QBLK + r32) * RS + hi * 8) * 2u;
#pragma unroll
    for (int d0 = 0; d0 < 8; ++d0) S.qr[d0] = LD16(qb_ + d0 * 32, qofs); }
    SBAR();
    finishSM(pA0, pA1, alA, l_reg, pa0, pa1, pa2, pa3); SBAR();
    pv_tile<0>(o, vb0, pa0, pa1, pa2, pa3, ACT(NT - 2));
    MASKT(pB0, pB1, NT - 1); partialSM(pB0, pB1, m_reg, mnB, alB); __syncthreads(); RESC(alB);
    finishSM(pB0, pB1, alB, l_reg, pa0, pa1, pa2, pa3); SBAR(); pv_tile<1>(o, vb0, pa0, pa1, pa2, pa3, ACT(NT - 1));
    SBAR(); SEAM_K0();
    if (hi == 0) li_l[r32] = l_reg; asm volatile("s_waitcnt lgkmcnt(0)" ::: "memory");
    float rli[16];
#pragma unroll
    for (int r = 0; r < 16; ++r) rli[r] = __builtin_amdgcn_rcpf(li_l[crow(r, hi)]);
    char* Ow = (char*)cur.O + (size_t)(qb * QB + wid * QBLK) * (RS * 2);
    const unsigned oofs = (unsigned)((4 * hi) * RS + r32) * 2u;
#pragma unroll
    for (int r = 0; r < 16; ++r) { const int orow = (r & 3) + 8 * (r >> 2);
#pragma unroll
        for (int d0 = 0; d0 < 4; ++d0) { const float v = o[d0][r] * rli[r];
            const float vn = __shfl_xor(v, 1);
            if ((r32 & 1) == 0) *(unsigned*)(Ow + (orow * RS + d0 * 32) * 2 + oofs) = cvtpk(v, vn); } }
    __syncthreads();
#undef RESC
#undef KBASE
#undef ACT
#undef MASKT
#undef SEAM_K0
#undef HALF_STEP
}
#undef LD16
#undef VMW
#undef VMWN
#undef SLOAD_H
#undef SWRITE_HK
#undef SWRITE_HV
#undef SWRITE_H
#undef KSWZ
#undef SBAR
}

constexpr size_t MiB = 1u << 20;
constexpr size_t WS_CTL = 0, CTL_ZERO_BYTES = 1 * MiB;
constexpr size_t WS_SSQ1 = 256 * 1024, WS_SSQ2 = 320 * 1024, WS_KM = 512 * 1024;
constexpr size_t WS_WIN = 1 * MiB;
constexpr size_t WS_WAC = 17 * MiB;
constexpr size_t WS_WOUT = 21 * MiB;
constexpr size_t WS_WGU = 23 * MiB;
constexpr size_t WS_WDN = 34 * MiB;
constexpr size_t WS_ROPE = 40 * MiB;
constexpr size_t WS_U = 42 * MiB;
constexpr size_t WS_V = 74 * MiB, WS_P = 106 * MiB, WS_BG = 138 * MiB, WS_SGA = 170 * MiB, WS_SGC = 202 * MiB;
constexpr size_t WS_T = 74 * MiB;
constexpr size_t WS_MG = 138 * MiB;
constexpr size_t WS_H1B = 170 * MiB;
constexpr size_t WS_HFF = 42 * MiB;
constexpr size_t WS_END = 256 * MiB;
constexpr int LDS_BYTES = 147456;
constexpr int NTHREADS = 512;

struct Args { const float* in[11]; float* out; unsigned char* ws; };

__device__ __forceinline__ size_t opq0() { size_t z = 0; asm volatile("" : "+s"(z)); return z; }
__device__ __forceinline__ float wave_sum(float v) {
#pragma unroll
    for (int o = 1; o < 64; o <<= 1) v += __shfl_xor(v, o);
    return v;
}
__device__ __forceinline__ void transpose_item(const float* W, int N, bf16_t* WT, int Kld, int k0, int n0, int dst_row0, const float* kscale, LAS float* scr, int lane) {
#pragma unroll 8
    for (int i = 0; i < 32; ++i) { const int kk = 2 * i + (lane >> 5); float v = W[(size_t)(k0 + kk) * N + n0 + (lane & 31)]; if (kscale) v *= kscale[k0 + kk]; scr[kk * 33 + (lane & 31)] = v; }
    asm volatile("s_waitcnt lgkmcnt(0)" ::: "memory");
    const int c = lane & 7;
#pragma unroll
    for (int j = 0; j < 4; ++j) { const int n = (lane >> 3) + 8 * j; const LAS float* s = scr + (8 * c) * 33 + n;
        u32x4 o; o.x = cvt_pk_bf16(s[0 * 33], s[1 * 33]); o.y = cvt_pk_bf16(s[2 * 33], s[3 * 33]); o.z = cvt_pk_bf16(s[4 * 33], s[5 * 33]); o.w = cvt_pk_bf16(s[6 * 33], s[7 * 33]);
        *(u32x4*)(WT + (size_t)(dst_row0 + n) * Kld + k0 + 8 * c) = o; }
    asm volatile("s_waitcnt lgkmcnt(0)" ::: "memory");
}
__device__ __forceinline__ int map_in(int n0) {
    if (n0 < 3072) return n0;
    if (n0 < 4096) { const int j = n0 - 3072; return 256 * (12 + (j >> 7)) + (j & 127); }
    if (n0 < 5120) return 5120 + (n0 - 4096);
    if (n0 < 6144) { const int j = n0 - 5120; return 256 * (12 + (j >> 7)) + 128 + (j & 127); }
    return n0;
}
__device__ __forceinline__ int map_gu(int n0) { const int j = n0 < DFF ? n0 : n0 - DFF; return 256 * (j >> 7) + (n0 < DFF ? 0 : 128) + (j & 127); }

__global__ void __launch_bounds__(NTHREADS, 2) mk_fwd(Args args) {
    extern __shared__ __attribute__((aligned(16))) unsigned char lds[];
    cg::grid_group grid = cg::this_grid();
    const int G = gridDim.x, bx = blockIdx.x;
#define TIDS() int tid = threadIdx.x; asm volatile("" : "+v"(tid)); const int lane = tid & 63, wave = __builtin_amdgcn_readfirstlane(tid >> 6); (void)lane; (void)wave
    const int vcu = (G % 8 == 0) ? (bx % 8) * (G / 8) + bx / 8 : bx;
#define OPQ(p) ((p) + opq0())
#define WSP(T, off) ((T*)(ws + (off)))
    LAS unsigned char* ldsl = (LAS unsigned char*)lds;

    {
        TIDS();
        unsigned char* ws = OPQ(args.ws);
        const float* x = OPQ(args.in[0]); const float* g_mix = OPQ(args.in[1]); const float* w_in = OPQ(args.in[2]); const float* w_a = OPQ(args.in[4]); const float* w_c = OPQ(args.in[5]);
        const float* w_out = OPQ(args.in[6]); const float* g_ffn = OPQ(args.in[7]); const float* w_gu = OPQ(args.in[8]); const float* w_dn = OPQ(args.in[9]);
        bf16_t* WIN = WSP(bf16_t, WS_WIN); bf16_t* WAC = WSP(bf16_t, WS_WAC); bf16_t* WOUT = WSP(bf16_t, WS_WOUT); bf16_t* WGU = WSP(bf16_t, WS_WGU); bf16_t* WDN = WSP(bf16_t, WS_WDN);
        float* ROPEC = WSP(float, WS_ROPE); float* ROPES = ROPEC + SEQ * 16; bf16_t* U = WSP(bf16_t, WS_U);
        LAS float* scr = (LAS float*)(ldsl + wave * 16384);
        const int gw = vcu * 8 + wave, NGW = G * 8;
        constexpr int I_IN = 16 * 256, I_SQ = 16 * 32, I_GU = 16 * 176, I_DN = 44 * 32;
        constexpr int NITEMS = I_IN + 3 * I_SQ + I_GU + I_DN;
        for (int it = gw; it < NITEMS; it += NGW) {
            int r = it;
            if (r < I_IN) { const int kb = r >> 8, nb = r & 255; transpose_item(w_in, INW, WIN, DM, 64 * kb, 32 * nb, map_in(32 * nb), nullptr, scr, lane); continue; } r -= I_IN;
            if (r < I_SQ) { const int kb = r >> 5, nb = r & 31; transpose_item(w_a, DM, WAC, DM, 64 * kb, 32 * nb, 32 * nb, nullptr, scr, lane); continue; } r -= I_SQ;
            if (r < I_SQ) { const int kb = r >> 5, nb = r & 31; transpose_item(w_c, DM, WAC, DM, 64 * kb, 32 * nb, 1024 + 32 * nb, nullptr, scr, lane); continue; } r -= I_SQ;
            if (r < I_SQ) { const int kb = r >> 5, nb = r & 31; transpose_item(w_out, DM, WOUT, DM, 64 * kb, 32 * nb, 32 * nb, nullptr, scr, lane); continue; } r -= I_SQ;
            if (r < I_GU) { const int kb = r / 176, nb = r % 176; transpose_item(w_gu, 2 * DFF, WGU, DM, 64 * kb, 32 * nb, map_gu(32 * nb), g_ffn, scr, lane); continue; } r -= I_GU;
            { const int kb = r >> 5, nb = r & 31; transpose_item(w_dn, DM, WDN, DFF, 64 * kb, 32 * nb, 32 * nb, nullptr, scr, lane); }
        }
        for (int m = gw; m < MTOK; m += NGW) {
            const f32x4* xr = (const f32x4*)(x + (size_t)m * DM) + lane; const f32x4* gr = (const f32x4*)g_mix + lane;
            f32x4 v[4]; float s = 0.f;
#pragma unroll
            for (int j = 0; j < 4; ++j) { v[j] = xr[64 * j]; s += (v[j].x * v[j].x + v[j].y * v[j].y) + (v[j].z * v[j].z + v[j].w * v[j].w); }
            const float rstd = 1.0f / sqrtf(wave_sum(s) * (1.0f / DM) + EPS);
            u32x2* o8 = (u32x2*)(U + (size_t)m * DM) + lane;
#pragma unroll
            for (int j = 0; j < 4; ++j) { const f32x4 gg = gr[64 * j]; u32x2 w; w.x = cvt_pk_bf16(v[j].x * rstd * gg.x, v[j].y * rstd * gg.y); w.y = cvt_pk_bf16(v[j].z * rstd * gg.z, v[j].w * rstd * gg.w); o8[64 * j] = w; }
        }
        for (int idx = (vcu * NTHREADS + tid); idx < SEQ * 16; idx += G * NTHREADS) {
            const int pos = idx >> 4, i = idx & 15;
            const double f = exp2(-(double)i * (18.931568569324174 / 16.0));
            const double a = (double)pos * f;
            ROPEC[idx] = (float)cos(a); ROPES[idx] = (float)sin(a);
        }
    }
    grid.sync();

    {
        unsigned char* ws = OPQ(args.ws); unsigned char* outb = (unsigned char*)OPQ(args.out);
        float* ROPEC = WSP(float, WS_ROPE);
        pg8::Gemm g{WSP(bf16_t, WS_U), WSP(bf16_t, WS_U), 1 << 30, WSP(bf16_t, WS_WIN), MTOK, INW, DM}; pg8::StaticOrder S; S.init(MTOK, INW, G, bx);
        pg8::EpiIn E{(bf16_t*)outb, (bf16_t*)(outb + 32 * MiB), WSP(bf16_t, WS_V), WSP(bf16_t, WS_P), WSP(bf16_t, WS_BG), WSP(bf16_t, WS_SGA), WSP(bf16_t, WS_SGC), WSP(float, WS_KM), ROPEC, ROPEC + SEQ * 16};
        pg8::gemm_phase<pg8::EpiIn, pg8::StaticOrder, true, true>(ldsl, g, S, E);
    }
    grid.sync();

    {
        TIDS();
        unsigned char* ws = OPQ(args.ws); unsigned char* outb = (unsigned char*)OPQ(args.out); const float* conv_w = OPQ(args.in[3]);
        bf16_t* PB = WSP(bf16_t, WS_P); bf16_t* BG = WSP(bf16_t, WS_BG); bf16_t* CZ = WSP(bf16_t, WS_U);
        bf16_t* QB_ = (bf16_t*)outb; bf16_t* KB_ = (bf16_t*)(outb + 32 * MiB); bf16_t* VB_ = WSP(bf16_t, WS_V); float* KM = WSP(float, WS_KM);
        for (int w = vcu * NTHREADS + tid; w < 128 * (MTOK / 16); w += G * NTHREADS) {
            const int cgp = w & 127, rc = w >> 7, c0 = cgp * 8, row0 = rc * 16;
            f32x4 w0a = *(const f32x4*)(conv_w + c0), w0b = *(const f32x4*)(conv_w + c0 + 4);
            f32x4 w1a = *(const f32x4*)(conv_w + DM + c0), w1b = *(const f32x4*)(conv_w + DM + c0 + 4);
            f32x4 w2a = *(const f32x4*)(conv_w + 2 * DM + c0), w2b = *(const f32x4*)(conv_w + 2 * DM + c0 + 4);
            f32x4 m2a = {0.f, 0.f, 0.f, 0.f}, m2b = m2a, m1a = m2a, m1b = m2a;
            if ((row0 & (SEQ - 1)) != 0) { unpack8(*(const u32x4*)(PB + (size_t)(row0 - 2) * DM + c0), m2a, m2b); unpack8(*(const u32x4*)(PB + (size_t)(row0 - 1) * DM + c0), m1a, m1b); }
#pragma unroll 4
            for (int r = 0; r < 16; ++r) { const size_t o = (size_t)(row0 + r) * DM + c0;
                f32x4 pa, pb, ba, bb; unpack8(*(const u32x4*)(PB + o), pa, pb); unpack8(*(const u32x4*)(BG + o), ba, bb);
                const f32x4 ya = ba * (w0a * m2a + w1a * m1a + w2a * pa), yb = bb * (w0b * m2b + w1b * m1b + w2b * pb);
                *(u32x4*)(CZ + o) = pack8u(ya, yb);
                m2a = m1a; m2b = m1b; m1a = pa; m1b = pb; }
        }
        const int nitems = (256 - vcu + G - 1) / G;
        if (vcu < 256) {
            const int nblocks = 2 * nitems;
            auto mkref = [&](int k) { const int item = vcu + (k >> 1) * G, bh = item >> 4, s = item & 15, b = bh >> 3, h = bh & 7;
                att::BlockRef r; const size_t base = (size_t)b * SEQ * DM + h * HD;
                r.Q = QB_ + base; r.K = KB_ + base; r.V = VB_ + base; r.O = QB_ + base; r.KM = KM + (size_t)bh * NKB * HD; r.qb = (k & 1) ? 31 - s : s; return r; };
            att::Seam S; att::BlockRef cur = mkref(0);
            att::moba_prime(cur, (char*)lds, S);
            for (int k = 0; k < nblocks; ++k) {
                const att::BlockRef nxt = (k + 1 < nblocks) ? mkref(k + 1) : cur;
                att::moba_block(cur, nxt, (char*)lds, S);
                cur = nxt;
            }
        }
    }
    grid.sync();

    {
        unsigned char* ws = OPQ(args.ws); unsigned char* outb = (unsigned char*)OPQ(args.out);
        pg8::Gemm g{(bf16_t*)outb, WSP(bf16_t, WS_U), 64, WSP(bf16_t, WS_WAC), 2 * MTOK, 2 * DM, DM}; pg8::BranchOrder S; S.s.init(MTOK, DM, G, bx);
        pg8::EpiBranch E{WSP(bf16_t, WS_SGA), WSP(bf16_t, WS_SGC), WSP(float, WS_T), WSP(bf16_t, WS_MG)};
        pg8::gemm_phase<pg8::EpiBranch, pg8::BranchOrder, true, true>(ldsl, g, S, E);
    }
    grid.sync();

    {
        unsigned char* ws = OPQ(args.ws);
        pg8::Gemm g{WSP(bf16_t, WS_MG), WSP(bf16_t, WS_MG), 1 << 30, WSP(bf16_t, WS_WOUT), MTOK, DM, DM}; pg8::StaticOrder S; S.init(MTOK, DM, G, bx);
        pg8::EpiH1 E{OPQ(args.in[0]), OPQ(args.out), WSP(bf16_t, WS_H1B), WSP(float, WS_SSQ1)};
        pg8::gemm_phase<pg8::EpiH1, pg8::StaticOrder, true, true>(ldsl, g, S, E);
    }
    grid.sync();

    {
        unsigned char* ws = OPQ(args.ws);
        pg8::Gemm g{WSP(bf16_t, WS_H1B), WSP(bf16_t, WS_H1B), 1 << 30, WSP(bf16_t, WS_WGU), MTOK, 2 * DFF, DM}; pg8::StaticOrder S; S.init(MTOK, 2 * DFF, G, bx);
        pg8::EpiSwiglu E{WSP(float, WS_SSQ1), WSP(bf16_t, WS_HFF)};
        pg8::gemm_phase<pg8::EpiSwiglu, pg8::StaticOrder, true, true>(ldsl, g, S, E);
    }
    grid.sync();

    {
        unsigned char* ws = OPQ(args.ws);
        pg8::Gemm g{WSP(bf16_t, WS_HFF), WSP(bf16_t, WS_HFF), 1 << 30, WSP(bf16_t, WS_WDN), MTOK, DM, DFF}; pg8::StaticOrder S; S.init(MTOK, DM, G, bx);
        pg8::EpiDown E{OPQ(args.out), WSP(float, WS_SSQ2)};
        pg8::gemm_phase<pg8::EpiDown, pg8::StaticOrder, true, true>(ldsl, g, S, E);
    }
    grid.sync();

    {
        TIDS();
        unsigned char* ws = OPQ(args.ws); float* out = OPQ(args.out); const float* g_final = OPQ(args.in[10]); const float* SSQ2 = WSP(float, WS_SSQ2);
        const int gw = vcu * 8 + wave, NGW = G * 8;
        for (int m = gw; m < MTOK; m += NGW) {
            f32x4* xr = (f32x4*)(out + (size_t)m * DM) + lane; const f32x4* gr = (const f32x4*)g_final + lane;
            const float rstd = 1.0f / sqrtf(SSQ2[m] * (1.0f / DM) + EPS);
#pragma unroll
            for (int j = 0; j < 4; ++j) { const f32x4 v = xr[64 * j], gg = gr[64 * j]; xr[64 * j] = v * rstd * gg; }
        }
    }
}

extern "C" void kernel_launch(void* const* d_in, const int* in_sizes, int n_in, void* d_out, int out_size, void* d_ws, size_t ws_size, hipStream_t stream) {
    static int grid = 0;
    if (grid == 0) {
        if (n_in != 11 || out_size != MTOK * DM || ws_size < WS_END) { fprintf(stderr, "kernel_launch: unexpected shapes (n_in %d out %d ws %zu)\n", n_in, out_size, ws_size); grid = -1; return; }
        int dev = 0, cus = 0, per_cu = 0;
        (void)hipGetDevice(&dev); (void)hipDeviceGetAttribute(&cus, hipDeviceAttributeMultiprocessorCount, dev);
        if (hipFuncSetAttribute((const void*)mk_fwd, hipFuncAttributeMaxDynamicSharedMemorySize, LDS_BYTES) != hipSuccess) { fprintf(stderr, "kernel_launch: hipFuncSetAttribute failed\n"); grid = -1; return; }
        if (hipOccupancyMaxActiveBlocksPerMultiprocessor(&per_cu, (const void*)mk_fwd, NTHREADS, LDS_BYTES) != hipSuccess || per_cu < 1) { fprintf(stderr, "kernel_launch: occupancy query failed (%d)\n", per_cu); grid = -1; return; }
        grid = cus * per_cu;
        if (grid > 256) grid = 256;
        grid &= ~7;
        fprintf(stderr, "kernel_launch: cus %d per_cu %d grid %d\n", cus, per_cu, grid);
    }
    if (grid <= 0) return;
    (void)hipMemsetAsync((char*)d_ws + WS_CTL, 0, CTL_ZERO_BYTES, stream);
    Args a{};
    for (int i = 0; i < 11; ++i) a.in[i] = (const float*)d_in[i];
    a.out = (float*)d_out; a.ws = (unsigned char*)d_ws;
    void* kargs[] = {&a};
    hipError_t e = hipLaunchCooperativeKernel((const void*)mk_fwd, dim3(grid), dim3(NTHREADS), kargs, LDS_BYTES, stream);
    if (e != hipSuccess) fprintf(stderr, "kernel_launch: cooperative launch failed: %s (grid %d)\n", hipGetErrorString(e), grid);
}
```

```cpp
#include <hip/hip_runtime.h>
#include <hip/hip_cooperative_groups.h>
#include <cstdio>
#include <cstdint>
namespace cg = cooperative_groups;

#define LAS __attribute__((address_space(3)))
typedef unsigned short bf16_t;
typedef short bf16x8 __attribute__((ext_vector_type(8)));
typedef short s16x4 __attribute__((ext_vector_type(4)));
typedef float f32x2 __attribute__((ext_vector_type(2)));
typedef float f32x4 __attribute__((ext_vector_type(4)));
typedef float f32x16 __attribute__((ext_vector_type(16)));
typedef unsigned u32x2 __attribute__((ext_vector_type(2)));
typedef unsigned u32x4 __attribute__((ext_vector_type(4)));

constexpr int BATCH = 2, SEQ = 8192, DM = 1024, MTOK = BATCH * SEQ, NHEAD = 8, HD = 128, NKB = SEQ / 256, DFF = 2816, INW = 8192;
constexpr float EPS = 1e-6f;
constexpr float QSCALE = 0.08838834764831845f * 1.4426950408889634f;

__device__ __forceinline__ unsigned cvt_pk_bf16(float lo, float hi) { unsigned r; asm volatile("v_cvt_pk_bf16_f32 %0, %1, %2" : "=v"(r) : "v"(lo), "v"(hi)); return r; }
__device__ __forceinline__ u32x4 pack8u(f32x4 a, f32x4 b) { u32x4 w; w.x = cvt_pk_bf16(a[0], a[1]); w.y = cvt_pk_bf16(a[2], a[3]); w.z = cvt_pk_bf16(b[0], b[1]); w.w = cvt_pk_bf16(b[2], b[3]); return w; }
__device__ __forceinline__ float bf_lo(unsigned w) { return __uint_as_float(w << 16); }
__device__ __forceinline__ float bf_hi(unsigned w) { return __uint_as_float(w & 0xffff0000u); }
__device__ __forceinline__ void unpack8(u32x4 w, f32x4& a, f32x4& b) { a = (f32x4){bf_lo(w.x), bf_hi(w.x), bf_lo(w.y), bf_hi(w.y)}; b = (f32x4){bf_lo(w.z), bf_hi(w.z), bf_lo(w.w), bf_hi(w.w)}; }
__device__ __forceinline__ float sigmoidf_(float x) { return 1.0f / (1.0f + __expf(-x)); }

namespace pg8 {
constexpr int BM = 256, BK = 64, HALF = 128, HTB = HALF * BK * 2, STAGE_BYTES = 8 * HTB, NXCD = 8, WGM = 8;
__host__ __device__ __forceinline__ int lds_byte(int r, int c) { const int st = (r >> 4) * 2 + (c >> 5), rr = r & 15, cc = c & 31, ob = rr * 64 + cc * 2; return st * 1024 + (ob ^ (((ob >> 9) & 1) << 5)); }
__host__ __device__ __forceinline__ void stage_rc(int b, int& R, int& C) { const int st = b / 1024, sb = b % 1024, swz = sb ^ (((sb >> 9) & 1) << 5); R = (st >> 1) * 16 + swz / 64; C = (st & 1) * 32 + (swz % 64) / 2; }
__host__ __device__ __forceinline__ int perm32(int rho) { const int n = rho >> 4, i = rho & 15; return 8 * (i >> 2) + 4 * n + (i & 3); }

struct Unit { int pm, pn; };
struct Gemm { const bf16_t* A; const bf16_t* A2; int pmsplit; const bf16_t* Bt; int M, N, K; };

struct StaticOrder {
    int nM, nN, nwg, G, c;
    __host__ __device__ void init(int M, int N, int G_, int c_) { nM = M / BM; nN = N / BM; nwg = nM * nN; G = G_; c = c_; }
    __host__ __device__ bool next(int i, Unit& u) const {
        const long L = (long)i * G + c; if (L >= nwg) return false;
        int wgid = (int)L; { const int q = nwg / NXCD, r = nwg % NXCD, xcd = wgid % NXCD, off = wgid / NXCD; wgid = (xcd < r ? xcd * (q + 1) : r * (q + 1) + (xcd - r) * q) + off; }
        const int nig = WGM * nN, gid = wgid / nig, fm = gid * WGM, gsz = (nM - fm) < WGM ? (nM - fm) : WGM;
        u.pm = fm + ((wgid % nig) % gsz); u.pn = (wgid % nig) / gsz; return true;
    }
    __device__ __forceinline__ void a_ready(const Unit&) const {}
    __device__ __forceinline__ void done(const Unit&) const {}
};
struct BranchOrder {
    StaticOrder s;
    __device__ bool next(int i, Unit& u) const { if (!s.next(i >> 1, u)) return false; if (i & 1) { u.pm += 64; u.pn += 4; } return true; }
    __device__ __forceinline__ void a_ready(const Unit&) const {}
    __device__ __forceinline__ void done(const Unit&) const {}
};

template <class Epi, class Sched, bool ALIGN_EPI = false, bool SP2 = false>
__device__ __forceinline__ void gemm_phase(LAS unsigned char* lds, const Gemm g, const Sched& S, const Epi& E) {
    int tid = threadIdx.x; asm volatile("" : "+v"(tid));
    const int wid = __builtin_amdgcn_readfirstlane(tid >> 6), lane = tid & 63, wr = wid >> 2, wc = wid & 3, fr = lane & 15, fq = lane >> 4;
    const int K = g.K, nt = K / BK;
    unsigned voffA[2], voffB[2];
#pragma unroll
    for (int i = 0; i < 2; ++i) { int R, C; stage_rc(tid * 16 + i * 8192, R, C); const int Rb = Epi::PERM ? ((R & ~31) + perm32(R & 31)) : R;
        voffA[i] = (unsigned)(R * K + C) * 2u; voffB[i] = (unsigned)(Rb * K + C) * 2u; }
    const size_t kstep = (size_t)(BK * 2);
    const size_t hstep = (size_t)HALF * K * 2;
    const size_t tstep = 2 * hstep;
    const unsigned ldsw = (unsigned)wid * 1024u;
    const int aoff = lds_byte(wr * 64 + fr, fq * 8), boff = lds_byte(wc * 32 + fr, fq * 8);
#define PG8_APTR(pm_) ((pm_) < g.pmsplit ? (const char*)g.A + (size_t)(pm_) * tstep : (const char*)g.A2 + (size_t)((pm_) - g.pmsplit) * tstep)
#define PG8_SA(b, h) (((b) * 2 + (h)) * HTB)
#define PG8_SB(b, h) ((4 + (b) * 2 + (h)) * HTB)
#define PG8_STAGE(bufoff, gbase, voff) do { _Pragma("unroll") for (int _i = 0; _i < 2; ++_i) \
        __builtin_amdgcn_global_load_lds((const unsigned*)((const char*)(gbase) + (voff)[_i]), (LAS unsigned*)(lds + (bufoff) + ldsw + _i * 8192), 16, 0, 0); } while (0)
#define PG8_LDA(dst, b, h) do { _Pragma("unroll") for (int m = 0; m < 4; ++m) _Pragma("unroll") for (int k = 0; k < 2; ++k) dst[m][k] = *(const LAS bf16x8*)(lds + PG8_SA(b, h) + aoff + m * 2048 + k * 1024); } while (0)
#define PG8_LDB(dst, b, h) do { _Pragma("unroll") for (int n = 0; n < 2; ++n) _Pragma("unroll") for (int k = 0; k < 2; ++k) dst[n][k] = *(const LAS bf16x8*)(lds + PG8_SB(b, h) + boff + n * 2048 + k * 1024); } while (0)
#define PG8_MMA(ai, bj, At, Bt) do { __builtin_amdgcn_s_setprio(1); _Pragma("unroll") for (int m = 0; m < 4; ++m) _Pragma("unroll") for (int n = 0; n < 2; ++n) _Pragma("unroll") for (int k = 0; k < 2; ++k) \
        acc[ai][bj][m][n] = __builtin_amdgcn_mfma_f32_16x16x32_bf16(Bt[n][k], At[m][k], acc[ai][bj][m][n], 0, 0, 0); __builtin_amdgcn_s_setprio(0); } while (0)
#define PG8_WAIT_V(n) asm volatile("s_waitcnt vmcnt(" #n ")" ::: "memory")
#define PG8_WAIT_L(n) asm volatile("s_waitcnt lgkmcnt(" #n ")" ::: "memory")
#define PG8_BAR __builtin_amdgcn_s_barrier()
#define PG8_SCHED __builtin_amdgcn_sched_barrier(0)
    Unit cur, nxt; int ui = 0;
    if (!S.next(0, cur)) return;
    f32x4 acc[2][2][4][2];
#pragma unroll
    for (int a = 0; a < 2; ++a)
#pragma unroll
        for (int b = 0; b < 2; ++b)
#pragma unroll
            for (int m = 0; m < 4; ++m)
#pragma unroll
                for (int n = 0; n < 2; ++n) acc[a][b][m][n] = (f32x4){0.f, 0.f, 0.f, 0.f};
    bf16x8 At[4][2], B0[2][2], B1[2][2];
    const char* cA = PG8_APTR(cur.pm); const char* cB = (const char*)g.Bt + (size_t)cur.pn * tstep;
    S.a_ready(cur);
    if constexpr (SP2) {
        PG8_STAGE(PG8_SB(0, 0), cB, voffB); PG8_STAGE(PG8_SB(0, 1), cB + hstep, voffB); PG8_STAGE(PG8_SA(0, 0), cA, voffA); PG8_STAGE(PG8_SA(0, 1), cA + hstep, voffA);
        if (wr == 1) PG8_BAR;
        PG8_WAIT_V(2); PG8_BAR;
        PG8_STAGE(PG8_SB(1, 0), cB + kstep, voffB); PG8_STAGE(PG8_SA(1, 0), cA + kstep, voffA); PG8_STAGE(PG8_SB(1, 1), cB + hstep + kstep, voffB);
        PG8_WAIT_V(6); PG8_BAR;
    } else {
        PG8_STAGE(PG8_SB(0, 0), cB, voffB); PG8_STAGE(PG8_SA(0, 0), cA, voffA); PG8_STAGE(PG8_SB(0, 1), cB + hstep, voffB); PG8_STAGE(PG8_SA(0, 1), cA + hstep, voffA);
        if (wr == 1) PG8_BAR;
        PG8_WAIT_V(4); PG8_BAR;
        PG8_STAGE(PG8_SB(1, 0), cB + kstep, voffB); PG8_STAGE(PG8_SA(1, 0), cA + kstep, voffA); PG8_STAGE(PG8_SB(1, 1), cB + hstep + kstep, voffB);
        PG8_WAIT_V(6); PG8_BAR;
    }
    for (;;) {
        const bool has_next = S.next(ui + 1, nxt);
        const char* nA = has_next ? PG8_APTR(nxt.pm) : cA; const char* nB = has_next ? (const char*)g.Bt + (size_t)nxt.pn * tstep : cB;
        for (int t = 0; t < nt; t += 2) {
            const bool last = (t == nt - 2);
            const char* a1 = cA + (size_t)(t + 1) * kstep;
            const char* a2 = last ? nA : cA + (size_t)(t + 2) * kstep; const char* b2 = last ? nB : cB + (size_t)(t + 2) * kstep;
            const char* a3 = a2 + kstep; const char* b3 = b2 + kstep;
            if (last && has_next) S.a_ready(nxt);
            if constexpr (SP2) {
            PG8_LDB(B0, 0, 0); PG8_LDB(B1, 0, 1); PG8_SCHED; PG8_LDA(At, 0, 0); PG8_STAGE(PG8_SA(1, 1), a1 + hstep, voffA);
            PG8_WAIT_V(8); PG8_WAIT_L(0); PG8_BAR; PG8_MMA(0, 0, At, B0); PG8_MMA(0, 1, At, B1); PG8_BAR; PG8_SCHED;
            PG8_LDA(At, 0, 1); PG8_STAGE(PG8_SB(0, 0), b2, voffB); PG8_STAGE(PG8_SB(0, 1), b2 + hstep, voffB); PG8_STAGE(PG8_SA(0, 0), a2, voffA);
            PG8_WAIT_V(8); PG8_WAIT_L(0); PG8_BAR; PG8_MMA(1, 0, At, B0); PG8_MMA(1, 1, At, B1); PG8_BAR; PG8_SCHED;
            PG8_LDB(B0, 1, 0); PG8_LDB(B1, 1, 1); PG8_SCHED; PG8_LDA(At, 1, 0); PG8_STAGE(PG8_SA(0, 1), a2 + hstep, voffA);
            PG8_WAIT_V(8); PG8_WAIT_L(0); PG8_BAR; PG8_MMA(0, 0, At, B0); PG8_MMA(0, 1, At, B1); PG8_BAR; PG8_SCHED;
            PG8_LDA(At, 1, 1); PG8_STAGE(PG8_SB(1, 0), b3, voffB); PG8_STAGE(PG8_SB(1, 1), b3 + hstep, voffB); PG8_STAGE(PG8_SA(1, 0), a3, voffA);
            PG8_WAIT_V(8); PG8_WAIT_L(0); PG8_BAR; PG8_MMA(1, 0, At, B0); PG8_MMA(1, 1, At, B1); PG8_BAR; PG8_SCHED;
            } else {
            PG8_LDB(B0, 0, 0); PG8_SCHED; PG8_LDA(At, 0, 0); PG8_STAGE(PG8_SA(1, 1), a1 + hstep, voffA);
            PG8_WAIT_L(8); PG8_BAR; PG8_WAIT_L(0); PG8_MMA(0, 0, At, B0); PG8_BAR; PG8_SCHED;
            PG8_LDB(B1, 0, 1); PG8_STAGE(PG8_SB(0, 0), b2, voffB);
            PG8_BAR; PG8_WAIT_L(0); PG8_MMA(0, 1, At, B1); PG8_BAR;
            PG8_LDA(At, 0, 1); PG8_STAGE(PG8_SA(0, 0), a2, voffA);
            PG8_BAR; PG8_WAIT_L(0); PG8_MMA(1, 0, At, B0); PG8_BAR; PG8_SCHED;
            PG8_STAGE(PG8_SB(0, 1), b2 + hstep, voffB);
            PG8_WAIT_V(6); PG8_BAR; PG8_MMA(1, 1, At, B1); PG8_BAR;
            PG8_LDB(B0, 1, 0); PG8_SCHED; PG8_LDA(At, 1, 0); PG8_STAGE(PG8_SA(0, 1), a2 + hstep, voffA);
            PG8_WAIT_L(8); PG8_BAR; PG8_WAIT_L(0); PG8_MMA(0, 0, At, B0); PG8_BAR; PG8_SCHED;
            PG8_LDB(B1, 1, 1); PG8_STAGE(PG8_SB(1, 0), b3, voffB);
            PG8_BAR; PG8_WAIT_L(0); PG8_MMA(0, 1, At, B1); PG8_BAR;
            PG8_LDA(At, 1, 1); PG8_STAGE(PG8_SA(1, 0), a3, voffA);
            PG8_BAR; PG8_WAIT_L(0); PG8_MMA(1, 0, At, B0); PG8_BAR; PG8_SCHED;
            PG8_STAGE(PG8_SB(1, 1), b3 + hstep, voffB);
            PG8_WAIT_V(6); PG8_BAR; PG8_MMA(1, 1, At, B1); PG8_BAR;
            }
        }
        if constexpr (ALIGN_EPI) { if (wr == 0) PG8_BAR; }
        E(acc, cur, wr, wc, fr, fq); S.done(cur);
        if (!has_next) break;
#pragma unroll
        for (int a = 0; a < 2; ++a)
#pragma unroll
            for (int b = 0; b < 2; ++b)
#pragma unroll
                for (int m = 0; m < 4; ++m)
#pragma unroll
                    for (int n = 0; n < 2; ++n) acc[a][b][m][n] = (f32x4){0.f, 0.f, 0.f, 0.f};
        cur = nxt; cA = nA; cB = nB; ++ui;
        if constexpr (ALIGN_EPI) { if (wr == 1) PG8_BAR; }
    }
    PG8_WAIT_V(0);
    if constexpr (!ALIGN_EPI) { if (wr == 0) PG8_BAR; }
    PG8_BAR;
#undef PG8_APTR
#undef PG8_SA
#undef PG8_SB
#undef PG8_STAGE
#undef PG8_LDA
#undef PG8_LDB
#undef PG8_MMA
#undef PG8_WAIT_V
#undef PG8_WAIT_L
#undef PG8_BAR
#undef PG8_SCHED
}

struct EpiIn {
    static constexpr bool PERM = true;
    bf16_t *Q, *K, *V, *P, *BG, *SGA, *SGC; float* KM; const float* RC; const float* RS;
    __device__ __forceinline__ void operator()(const f32x4 (&acc)[2][2][4][2], const Unit& u, int wr, int wc, int fr, int fq) const {
        const int pn = u.pn, row0 = u.pm * BM + wr * 64 + fr, cw = wc * 32 + 8 * fq;
        if (pn < 8) {
            const bool isq = pn < 4; bf16_t* O = (isq ? Q : K) + (pn & 3) * 256 + cw;
            const float sgn = fq < 2 ? -1.f : 1.f;
            float ks[2][2][4];
#pragma unroll
            for (int bj = 0; bj < 2; ++bj)
#pragma unroll
                for (int n = 0; n < 2; ++n)
#pragma unroll
                    for (int e = 0; e < 4; ++e) ks[bj][n][e] = 0.f;
#pragma unroll
            for (int ai = 0; ai < 2; ++ai)
#pragma unroll
                for (int m = 0; m < 4; ++m) {
                    const int row = row0 + ai * HALF + m * 16, pos = row & (SEQ - 1);
                    f32x4 c0 = {1.f, 1.f, 1.f, 1.f}, c1 = c0, s0 = {0.f, 0.f, 0.f, 0.f}, s1 = s0;
                    if (wc == 0) { const float* rc = RC + pos * 16 + 8 * (fq & 1); const float* rs = RS + pos * 16 + 8 * (fq & 1);
                        c0 = *(const f32x4*)rc; c1 = *(const f32x4*)(rc + 4); s0 = *(const f32x4*)rs; s1 = *(const f32x4*)(rs + 4); }
#pragma unroll
                    for (int bj = 0; bj < 2; ++bj) {
                        f32x4 v0 = acc[ai][bj][m][0], v1 = acc[ai][bj][m][1];
                        if (wc == 0) {
                            f32x4 p0, p1;
#pragma unroll
                            for (int e = 0; e < 4; ++e) { p0[e] = __shfl_xor(v0[e], 32); p1[e] = __shfl_xor(v1[e], 32); }
                            v0 = v0 * c0 + (p0 * s0) * sgn; v1 = v1 * c1 + (p1 * s1) * sgn;
                        }
                        if (isq) { v0 = v0 * QSCALE; v1 = v1 * QSCALE; }
                        else {
#pragma unroll
                            for (int e = 0; e < 4; ++e) { ks[bj][0][e] += v0[e]; ks[bj][1][e] += v1[e]; } }
                        *(u32x4*)(O + (size_t)row * DM + bj * HALF) = pack8u(v0, v1);
                    }
                }
            if (!isq) {
                float* kmb = KM + ((size_t)((u.pm >> 5) * NHEAD + 2 * (pn & 3)) * NKB + (u.pm & 31)) * HD + cw;
#pragma unroll
                for (int bj = 0; bj < 2; ++bj)
#pragma unroll
                    for (int n = 0; n < 2; ++n)
#pragma unroll
                        for (int e = 0; e < 4; ++e) { float v = ks[bj][n][e];
                            v += __shfl_xor(v, 1); v += __shfl_xor(v, 2); v += __shfl_xor(v, 4); v += __shfl_xor(v, 8);
                            if (fr == 0) atomicAdd(kmb + (size_t)bj * NKB * HD + 4 * n + e, v); }
            }
        } else if (pn < 12 || (pn >= 20 && pn < 24)) {
            bf16_t* O = (pn < 12 ? V + (pn - 8) * 256 : BG + (pn - 20) * 256) + cw;
#pragma unroll
            for (int ai = 0; ai < 2; ++ai)
#pragma unroll
                for (int m = 0; m < 4; ++m) { const int row = row0 + ai * HALF + m * 16;
#pragma unroll
                    for (int bj = 0; bj < 2; ++bj) *(u32x4*)(O + (size_t)row * DM + bj * HALF) = pack8u(acc[ai][bj][m][0], acc[ai][bj][m][1]); }
        } else if (pn < 20) {
            bf16_t* O = P + (pn - 12) * 128 + cw;
#pragma unroll
            for (int ai = 0; ai < 2; ++ai)
#pragma unroll
                for (int m = 0; m < 4; ++m) { const int row = row0 + ai * HALF + m * 16;
                    *(u32x4*)(O + (size_t)row * DM) = pack8u(acc[ai][0][m][0] * acc[ai][1][m][0], acc[ai][0][m][1] * acc[ai][1][m][1]); }
        } else {
            bf16_t* O = (pn < 28 ? SGA + (pn - 24) * 256 : SGC + (pn - 28) * 256) + cw;
#pragma unroll
            for (int ai = 0; ai < 2; ++ai)
#pragma unroll
                for (int m = 0; m < 4; ++m) { const int row = row0 + ai * HALF + m * 16;
#pragma unroll
                    for (int bj = 0; bj < 2; ++bj) { f32x4 v0 = acc[ai][bj][m][0], v1 = acc[ai][bj][m][1];
#pragma unroll
                        for (int e = 0; e < 4; ++e) { v0[e] = sigmoidf_(v0[e]); v1[e] = sigmoidf_(v1[e]); }
                        *(u32x4*)(O + (size_t)row * DM + bj * HALF) = pack8u(v0, v1); } }
        }
    }
};
struct EpiBranch {
    static constexpr bool PERM = true;
    const bf16_t *SGA, *SGC; float* T; bf16_t* MG;
    __device__ __forceinline__ void operator()(const f32x4 (&acc)[2][2][4][2], const Unit& u, int wr, int wc, int fr, int fq) const {
        const int type = u.pm >> 6, pm = u.pm & 63, pn = u.pn & 3;
        const int row0 = pm * BM + wr * 64 + fr, col0 = pn * BM + wc * 32 + 8 * fq;
        const bf16_t* SG = type ? SGC : SGA;
#pragma unroll
        for (int ai = 0; ai < 2; ++ai)
#pragma unroll
            for (int m = 0; m < 4; ++m) { const size_t ro = (size_t)(row0 + ai * HALF + m * 16) * DM + col0;
#pragma unroll
                for (int bj = 0; bj < 2; ++bj) { const size_t o = ro + bj * HALF;
                    f32x4 g0, g1; unpack8(*(const u32x4*)(SG + o), g0, g1);
                    f32x4 v0 = acc[ai][bj][m][0] * g0, v1 = acc[ai][bj][m][1] * g1;
                    if (type == 0) { *(f32x4*)(T + o) = v0; *(f32x4*)(T + o + 4) = v1; }
                    else { v0 = v0 + *(const f32x4*)(T + o); v1 = v1 + *(const f32x4*)(T + o + 4); *(u32x4*)(MG + o) = pack8u(v0, v1); } } }
    }
};
struct EpiH1 {
    static constexpr bool PERM = false;
    const float* X; float* H1; bf16_t* H1B; float* SSQ;
    __device__ __forceinline__ void operator()(const f32x4 (&acc)[2][2][4][2], const Unit& u, int wr, int wc, int fr, int fq) const {
        const int row0 = u.pm * BM + wr * 64 + fr, col0 = u.pn * BM + wc * 32 + 4 * fq;
#pragma unroll
        for (int ai = 0; ai < 2; ++ai)
#pragma unroll
            for (int m = 0; m < 4; ++m) { const int row = row0 + ai * HALF + m * 16; const size_t ro = (size_t)row * DM + col0; float ss = 0.f;
#pragma unroll
                for (int bj = 0; bj < 2; ++bj)
#pragma unroll
                    for (int n = 0; n < 2; ++n) { const size_t o = ro + bj * HALF + n * 16;
                        const f32x4 h = *(const f32x4*)(X + o) + acc[ai][bj][m][n];
                        *(f32x4*)(H1 + o) = h; u32x2 w; w.x = cvt_pk_bf16(h[0], h[1]); w.y = cvt_pk_bf16(h[2], h[3]); *(u32x2*)(H1B + o) = w;
                        ss += (h[0] * h[0] + h[1] * h[1]) + (h[2] * h[2] + h[3] * h[3]); }
                ss += __shfl_xor(ss, 16); ss += __shfl_xor(ss, 32);
                if (fq == 0) atomicAdd(SSQ + row, ss); }
    }
};
struct EpiSwiglu {
    static constexpr bool PERM = true;
    const float* SSQ; bf16_t* HFF;
    __device__ __forceinline__ void operator()(const f32x4 (&acc)[2][2][4][2], const Unit& u, int wr, int wc, int fr, int fq) const {
        const int row0 = u.pm * BM + wr * 64 + fr, col0 = u.pn * HALF + wc * 32 + 8 * fq;
#pragma unroll
        for (int ai = 0; ai < 2; ++ai)
#pragma unroll
            for (int m = 0; m < 4; ++m) { const int row = row0 + ai * HALF + m * 16;
                const float rstd = 1.0f / sqrtf(SSQ[row] * (1.0f / DM) + EPS);
                f32x4 o[2];
#pragma unroll
                for (int n = 0; n < 2; ++n)
#pragma unroll
                    for (int e = 0; e < 4; ++e) { const float gg = acc[ai][0][m][n][e] * rstd, uu = acc[ai][1][m][n][e] * rstd; o[n][e] = gg * sigmoidf_(gg) * uu; }
                *(u32x4*)(HFF + (size_t)row * DFF + col0) = pack8u(o[0], o[1]); }
    }
};
struct EpiDown {
    static constexpr bool PERM = false;
    float* OUT; float* SSQ;
    __device__ __forceinline__ void operator()(const f32x4 (&acc)[2][2][4][2], const Unit& u, int wr, int wc, int fr, int fq) const {
        const int row0 = u.pm * BM + wr * 64 + fr, col0 = u.pn * BM + wc * 32 + 4 * fq;
#pragma unroll
        for (int ai = 0; ai < 2; ++ai)
#pragma unroll
            for (int m = 0; m < 4; ++m) { const int row = row0 + ai * HALF + m * 16; const size_t ro = (size_t)row * DM + col0; float ss = 0.f;
#pragma unroll
                for (int bj = 0; bj < 2; ++bj)
#pragma unroll
                    for (int n = 0; n < 2; ++n) { const size_t o = ro + bj * HALF + n * 16;
                        const f32x4 h = *(const f32x4*)(OUT + o) + acc[ai][bj][m][n];
                        *(f32x4*)(OUT + o) = h;
                        ss += (h[0] * h[0] + h[1] * h[1]) + (h[2] * h[2] + h[3] * h[3]); }
                ss += __shfl_xor(ss, 16); ss += __shfl_xor(ss, 32);
                if (fq == 0) atomicAdd(SSQ + row, ss); }
    }
};
}

namespace att {
constexpr int NW = 8, QBLK = 32, KVBLK = 64, QB = NW * QBLK, D = 128, RS = DM;
constexpr int SHM_V = KVBLK * D * 2, SHM_K = KVBLK * D * 2;
constexpr int LDS_BYTES = 2 * SHM_V + 2 * SHM_K + NW * 64 * 4;
constexpr float THR = 8.f;
#define KSWZ(row, colB) ((row) * 256 + ((colB) ^ (((row) & 7) << 4)))
#define SBAR() __builtin_amdgcn_sched_barrier(0)
__device__ __forceinline__ int v_st(int k, int c) { const int kk = (k & ~0xC) | ((k & 4) << 1) | ((k & 8) >> 1); return ((kk >> 3) * 4 + (c >> 5)) * 512 + ((kk & 7) * 32 + (c & 31)) * 2; }
__device__ __forceinline__ int v_rd_base(int lane) { return ((lane & 3) << 3) | (((lane >> 2) & 3) << 6) | (((lane >> 4) & 1) << 5) | (((lane >> 5) & 1) << 8); }
constexpr int v_rd_off(int d0, int ks, int half) { return d0 * 512 + ks * 4096 + half * 2048; }
__device__ __forceinline__ int crow(int r, int hi) { return (r & 3) + 8 * (r >> 2) + 4 * hi; }
__device__ __forceinline__ unsigned cvtpk(float lo, float hi) { unsigned r; asm volatile("v_cvt_pk_bf16_f32 %0, %1, %2" : "=v"(r) : "v"(lo), "v"(hi)); return r; }
__device__ __forceinline__ bf16x8 load8(const bf16_t* p) { return *reinterpret_cast<const bf16x8*>(p); }
__device__ __forceinline__ void mask_causal(f32x16& p0, f32x16& p1, int dq) {
    const float NEG = -__builtin_inff();
#pragma unroll
    for (int r = 0; r < 16; ++r) { const int c = (r & 3) + 8 * (r >> 2);
        if (dq - c < 0) p0[r] = NEG;
        if (dq - c - 32 < 0) p1[r] = NEG; }
}
__device__ __forceinline__ void mask_row(f32x16& p0, f32x16& p1, bool keep) {
    const float NEG = -__builtin_inff();
#pragma unroll
    for (int r = 0; r < 16; ++r) { p0[r] = keep ? p0[r] : NEG; p1[r] = keep ? p1[r] : NEG; }
}
__device__ __forceinline__ void partialSM(f32x16& p0, f32x16& p1, float& m_reg, float& mn, float& alpha) {
    float pmax = p0[0];
#pragma unroll
    for (int r = 1; r < 16; ++r) pmax = fmaxf(pmax, p0[r]);
#pragma unroll
    for (int r = 0; r < 16; ++r) pmax = fmaxf(pmax, p1[r]);
    { auto rr = __builtin_amdgcn_permlane32_swap(__float_as_uint(pmax), __float_as_uint(pmax), false, false);
      pmax = fmaxf(__uint_as_float(rr[0]), __uint_as_float(rr[1])); }
    if (__builtin_expect(__all((pmax - m_reg) <= THR), 1)) { mn = m_reg; alpha = 1.f; }
    else { mn = fmaxf(m_reg, pmax); alpha = __builtin_amdgcn_exp2f(m_reg - mn); m_reg = mn; }
#pragma unroll
    for (int r = 0; r < 16; ++r) p0[r] = p0[r] - mn;
#pragma unroll
    for (int r = 0; r < 16; ++r) p1[r] = p1[r] - mn;
#pragma unroll
    for (int r = 0; r < 16; ++r) p0[r] = __builtin_amdgcn_exp2f(p0[r]);
}
__device__ __forceinline__ void finishSM(f32x16& p0, f32x16& p1, float alpha, float& l_reg, bf16x8& pa0, bf16x8& pa1, bf16x8& pa2, bf16x8& pa3) {
#pragma unroll
    for (int r = 0; r < 16; ++r) p1[r] = __builtin_amdgcn_exp2f(p1[r]);
    float ps = 0;
#pragma unroll
    for (int r = 0; r < 16; ++r) ps += p0[r];
#pragma unroll
    for (int r = 0; r < 16; ++r) ps += p1[r];
    { auto rr = __builtin_amdgcn_permlane32_swap(__float_as_uint(ps), __float_as_uint(ps), false, false);
      ps = __uint_as_float(rr[0]) + __uint_as_float(rr[1]); }
    l_reg = l_reg * alpha + ps;
#define PK4(P, B_, OUT) do { unsigned a0 = cvtpk(P[B_+0], P[B_+1]), a1 = cvtpk(P[B_+2], P[B_+3]);                          \
        unsigned b0 = cvtpk(P[B_+4], P[B_+5]), b1 = cvtpk(P[B_+6], P[B_+7]);                                             \
        auto r0 = __builtin_amdgcn_permlane32_swap(a0, b0, false, false); auto r1 = __builtin_amdgcn_permlane32_swap(a1, b1, false, false); \
        u32x4 w = {r0[0], r1[0], r0[1], r1[1]}; OUT = *reinterpret_cast<bf16x8*>(&w); } while (0)
    PK4(p0, 0, pa0); PK4(p0, 8, pa1); PK4(p1, 0, pa2); PK4(p1, 8, pa3);
#undef PK4
}
template <int KB>
__device__ __forceinline__ void qkt(f32x16& p0, f32x16& p1, const char* K_lds, int r32, int hi, const bf16x8* qr, bool act) {
    if (!act) { const float NEG = -__builtin_inff();
#pragma unroll
        for (int r = 0; r < 16; ++r) { p0[r] = NEG; p1[r] = NEG; } return; }
    p0 = f32x16{}; p1 = f32x16{};
    const char* kb[4];
#pragma unroll
    for (int dd = 0; dd < 4; ++dd) kb[dd] = K_lds + KB * SHM_K + KSWZ(r32, (dd * 16 + hi * 8) * 2);
#pragma unroll
    for (int d0 = 0; d0 < 8; ++d0) { const char* a = kb[d0 & 3] + (d0 >> 2) * 128;
        bf16x8 b0 = *reinterpret_cast<const bf16x8*>(a);
        bf16x8 b1 = *reinterpret_cast<const bf16x8*>(a + 32 * 256);
        p0 = __builtin_amdgcn_mfma_f32_32x32x16_bf16(b0, qr[d0], p0, 0, 0, 0);
        p1 = __builtin_amdgcn_mfma_f32_32x32x16_bf16(b1, qr[d0], p1, 0, 0, 0); }
}
template <int VB>
__device__ __forceinline__ void pv_tile(f32x16* o, int vb0, bf16x8 pa0, bf16x8 pa1, bf16x8 pa2, bf16x8 pa3, bool act) {
    if (!act) return;
#define TRRD(dst, off) asm volatile("ds_read_b64_tr_b16 %0, %1 offset:%2" : "=&v"(dst) : "v"(vb0), "i"(off) : "memory")
#define PV_D0(d0) do { s16x4 l0, l1, l2, l3, h0, h1, h2, h3; constexpr int b_ = VB * SHM_V + v_rd_off(d0, 0, 0); \
        TRRD(l0, b_); TRRD(h0, b_ + 2048); TRRD(l1, b_ + 4096); TRRD(h1, b_ + 6144); TRRD(l2, b_ + 8192); TRRD(h2, b_ + 10240); TRRD(l3, b_ + 12288); TRRD(h3, b_ + 14336); \
        asm volatile("s_waitcnt lgkmcnt(0)" ::: "memory"); SBAR();   \
        o[d0] = __builtin_amdgcn_mfma_f32_32x32x16_bf16(pa0, (bf16x8){l0[0], l0[1], l0[2], l0[3], h0[0], h0[1], h0[2], h0[3]}, o[d0], 0, 0, 0);   \
        o[d0] = __builtin_amdgcn_mfma_f32_32x32x16_bf16(pa1, (bf16x8){l1[0], l1[1], l1[2], l1[3], h1[0], h1[1], h1[2], h1[3]}, o[d0], 0, 0, 0);   \
        o[d0] = __builtin_amdgcn_mfma_f32_32x32x16_bf16(pa2, (bf16x8){l2[0], l2[1], l2[2], l2[3], h2[0], h2[1], h2[2], h2[3]}, o[d0], 0, 0, 0);   \
        o[d0] = __builtin_amdgcn_mfma_f32_32x32x16_bf16(pa3, (bf16x8){l3[0], l3[1], l3[2], l3[3], h3[0], h3[1], h3[2], h3[3]}, o[d0], 0, 0, 0); } while (0)
    PV_D0(0); PV_D0(1); PV_D0(2); PV_D0(3);
#undef PV_D0
#undef TRRD
}
struct BlockRef { const bf16_t* Q; const bf16_t* K; const bf16_t* V; bf16_t* O; const float* KM; int qb; };
struct Seam { bf16x8 qr[8]; bf16x8 st_v0, st_v1, st_k0, st_k1; };
#define LD16(base, off) (*reinterpret_cast<const bf16x8*>((const char*)(base) + (off)))
#define VMW() asm volatile("s_waitcnt vmcnt(0)" ::: "memory")
#define VMWN(n) asm volatile("s_waitcnt vmcnt(%0)" :: "i"(n) : "memory")
#define SLOAD_H(Kp, Vp, k0) do { const char* kb_ = (const char*)(Kp) + (size_t)(k0) * (RS * 2); const char* vb_ = (const char*)(Vp) + (size_t)(k0) * (RS * 2); \
                         S.st_v0 = LD16(vb_, lofs); S.st_v1 = LD16(vb_ + 32 * RS * 2, lofs);              \
                         S.st_k0 = LD16(kb_, lofs); S.st_k1 = LD16(kb_ + 32 * RS * 2, lofs); } while (0)
#define SWRITE_HK(bf) do { *(bf16x8*)(K_lds + (bf) * SHM_K + kws) = S.st_k0; *(bf16x8*)(K_lds + (bf) * SHM_K + kws + 32 * 256) = S.st_k1; } while (0)
#define SWRITE_HV(bf) do { *(bf16x8*)(V_lds + (bf) * SHM_V + vst0) = S.st_v0; *(bf16x8*)(V_lds + (bf) * SHM_V + vst1) = S.st_v1; } while (0)
#define SWRITE_H(bf) do { SWRITE_HV(bf); SWRITE_HK(bf); } while (0)
__device__ __forceinline__ void moba_prime(const BlockRef& cur, char* lds, Seam& S) {
    int tid = threadIdx.x; asm volatile("" : "+v"(tid));
    const int wid = __builtin_amdgcn_readfirstlane(tid >> 6), lane = tid & 63, r32 = lane & 31, hi = lane >> 5;
    const int sr = tid >> 4, sc = (tid & 15) * 8, kws = KSWZ(sr, sc * 2); char* K_lds = lds + 2 * SHM_V;
    const unsigned lofs = (unsigned)(sr * RS + sc) * 2u, qofs = (unsigned)((wid * QBLK + r32) * RS + hi * 8) * 2u;
    { const char* qb_ = (const char*)cur.Q + (size_t)cur.qb * (QB * RS * 2);
#pragma unroll
    for (int d0 = 0; d0 < 8; ++d0) S.qr[d0] = LD16(qb_ + d0 * 32, qofs); }
    SLOAD_H(cur.K, cur.V, 0); VMW(); SWRITE_HK(0);
    __syncthreads();
}
__device__ __forceinline__ void moba_block(const BlockRef& cur, const BlockRef& nxt, char* lds, Seam& S) {
    int tid = threadIdx.x; asm volatile("" : "+v"(tid));
    const int wid = __builtin_amdgcn_readfirstlane(tid >> 6), lane = tid & 63, r32 = lane & 31, hi = lane >> 5;
    const int qb = cur.qb, NT = 4 * (qb + 1);
    const int qrel = wid * QBLK;
    char* V_lds = lds; char* K_lds = lds + 2 * SHM_V;
    float* ws = (float*)(lds + 2 * SHM_V + 2 * SHM_K) + wid * 64; float* li_l = ws, * al_l = ws + 32;
    unsigned sel = 0u;
    {
        f32x16 g = f32x16{};
#pragma unroll
        for (int d0 = 0; d0 < 8; ++d0) {
            const char* kp = (const char*)cur.KM + d0 * 64; const unsigned kofs = (unsigned)(r32 * D + hi * 8) * 4u;
            const f32x4 a = *(const f32x4*)(kp + kofs), b = *(const f32x4*)(kp + 16 + kofs);
            const u32x4 wh = pack8u(a, b); f32x4 ah, bh; unpack8(wh, ah, bh);
            const u32x4 wl = pack8u(a - ah, b - bh);
            g = __builtin_amdgcn_mfma_f32_32x32x16_bf16(*reinterpret_cast<const bf16x8*>(&wh), S.qr[d0], g, 0, 0, 0);
            g = __builtin_amdgcn_mfma_f32_32x32x16_bf16(*reinterpret_cast<const bf16x8*>(&wl), S.qr[d0], g, 0, 0, 0);
        }
        const float NEG = -__builtin_inff();
#pragma unroll
        for (int r = 0; r < 16; ++r) if (crow(r, hi) >= qb) g[r] = NEG;
#pragma unroll
        for (int round = 0; round < 3; ++round) {
            float bv = NEG; int bn = 64;
#pragma unroll
            for (int r = 0; r < 16; ++r) if (g[r] > bv) { bv = g[r]; bn = crow(r, hi); }
            const float ov = __shfl_xor(bv, 32); const int on = __shfl_xor(bn, 32);
            if (ov > bv || (ov == bv && on < bn)) { bv = ov; bn = on; }
            if (bv > NEG) sel |= 1u << bn;
#pragma unroll
            for (int r = 0; r < 16; ++r) if (crow(r, hi) == bn) g[r] = NEG;
        }
    }
    float m_reg = -1e30f, l_reg = 0; f32x16 o[4] = {};
    const int sr = tid >> 4, sc = (tid & 15) * 8, vst0 = v_st(sr, sc), vst1 = v_st(32 + sr, sc), kws = KSWZ(sr, sc * 2);
    const unsigned lofs = (unsigned)(sr * RS + sc) * 2u;
    const int vb0 = (int)(uintptr_t)V_lds + v_rd_base(lane);
    const bf16_t* Kh = cur.K; const bf16_t* Vh = cur.V;
#define RESC(a) do { if (__any((a) < 1.f)) { if (hi == 0) al_l[r32] = (a); asm volatile("s_waitcnt lgkmcnt(0)" ::: "memory");              \
                     for (int d_ = 0; d_ < 4; ++d_) for (int r = 0; r < 16; ++r) o[d_][r] *= al_l[crow(r, hi)]; } } while (0)
#define KBASE(t) ((t) * KVBLK)
#define ACT(t) ((((t) >> 2) < qb) ? (__any((int)((sel >> ((t) >> 2)) & 1u)) != 0) : ((((t) & 3) * KVBLK) <= qrel + QBLK - 1))
#define MASKT(P0_, P1_, t) do { const int n_ = (t) >> 2; if (n_ < qb) { const bool keep_ = ((sel >> n_) & 1u) != 0u; if (!__all((int)keep_)) mask_row(P0_, P1_, keep_); } \
        else { const int kbl_ = ((t) & 3) * KVBLK; if (kbl_ + KVBLK - 1 > qrel) mask_causal(P0_, P1_, qrel + r32 - 4 * hi - kbl_); } } while (0)
    constexpr int NQL = 8;
#define SEAM_K0() do { VMWN(NQL); SWRITE_HK(0); SBAR(); } while (0)
    f32x16 pA0, pA1, pB0, pB1; float mnA, mnB, alA, alB; bf16x8 pa0, pa1, pa2, pa3;
    SWRITE_HV(0); SBAR();
    if (NT > 1) { SLOAD_H(Kh, Vh, KBASE(1)); }
    SBAR(); qkt<0>(pA0, pA1, K_lds, r32, hi, S.qr, ACT(0));
    MASKT(pA0, pA1, 0); partialSM(pA0, pA1, m_reg, mnA, alA);
    if (NT > 1) { VMW(); SWRITE_H(1); }
    __syncthreads();
#define HALF_STEP(PX0, PX1, mnX, alX, PY0, PY1, alY, t, KB, VB, SB) do {                                                      \
        SBAR(); qkt<KB>(PX0, PX1, K_lds, r32, hi, S.qr, ACT(t));                                             \
        finishSM(PY0, PY1, alY, l_reg, pa0, pa1, pa2, pa3); SBAR();                                                           \
        if ((t) + 1 < NT) { SLOAD_H(Kh, Vh, KBASE((t) + 1)); SBAR(); }                                               \
        pv_tile<VB>(o, vb0, pa0, pa1, pa2, pa3, ACT((t) - 1)); MASKT(PX0, PX1, (t)); partialSM(PX0, PX1, m_reg, mnX, alX);                                        \
        __syncthreads();                                                                                                      \
        if ((t) + 1 < NT) { VMW(); SWRITE_H(SB); }                                                                          \
        RESC(alX); __syncthreads(); } while (0)
    for (int t = 1; t + 1 < NT; t += 2) {
        HALF_STEP(pB0, pB1, mnB, alB, pA0, pA1, alA, t, 1, 0, 0);
        HALF_STEP(pA0, pA1, mnA, alA, pB0, pB1, alB, t + 1, 0, 1, 1);
    }
    SBAR(); qkt<1>(pB0, pB1, K_lds, r32, hi, S.qr, ACT(NT - 1)); SBAR();
    SLOAD_H(nxt.K, nxt.V, 0); SBAR();
    { const char* qb_ = (const char*)nxt.Q + (size_t)nxt.qb * (QB * RS * 2); const unsigned qofs = (unsigned)((wid * QBLK + r32) * RS + hi * 8) * 2u;
#pragma unroll
    for (int d0 = 0; d0 < 8; ++d0) S.qr[d0] = LD16(qb_ + d0 * 32, qofs); }
    SBAR();
    finishSM(pA0, pA1, alA, l_reg, pa0, pa1, pa2, pa3); SBAR();
    pv_tile<0>(o, vb0, pa0, pa1, pa2, pa3, ACT(NT - 2));
    MASKT(pB0, pB1, NT - 1); partialSM(pB0, pB1, m_reg, mnB, alB); __syncthreads(); RESC(alB);
    finishSM(pB0, pB1, alB, l_reg, pa0, pa1, pa2, pa3); SBAR(); pv_tile<1>(o, vb0, pa0, pa1, pa2, pa3, ACT(NT - 1));
    SBAR(); SEAM_K0();
    if (hi == 0) li_l[r32] = l_reg; asm volatile("s_waitcnt lgkmcnt(0)" ::: "memory");
    float rli[16];
#pragma unroll
    for (int r = 0; r < 16; ++r) rli[r] = __builtin_amdgcn_rcpf(li_l[crow(r, hi)]);
    char* Ow = (char*)cur.O + (size_t)(qb * QB + wid * QBLK) * (RS * 2);
    const unsigned oofs = (unsigned)((4 * hi) * RS + r32) * 2u;
#pragma unroll
    for (int r = 0; r < 16; ++r) { const int orow = (r & 3) + 8 * (r >> 2);
#pragma unroll
        for (int d0 = 0; d0 < 4; ++d0) { const float v = o[d0][r] * rli[r];
            const float vn = __shfl_xor(v, 1);
            if ((r32 & 1) == 0) *(unsigned*)(Ow + (orow * RS + d0 * 32) * 2 + oofs) = cvtpk(v, vn); } }
    __syncthreads();
#undef RESC
#undef KBASE
#undef ACT
#undef MASKT
#undef SEAM_K0
#undef HALF_STEP
}
#undef LD16
#undef VMW
#undef VMWN
#undef SLOAD_H
#undef SWRITE_HK
#undef SWRITE_HV
#undef SWRITE_H
#undef KSWZ
#undef SBAR
}

constexpr size_t MiB = 1u << 20;
constexpr size_t WS_CTL = 0, CTL_ZERO_BYTES = 1 * MiB;
constexpr size_t WS_BAR = 16384;
constexpr size_t WS_SSQ1 = 256 * 1024, WS_SSQ2 = 320 * 1024, WS_KM = 512 * 1024;
constexpr size_t WS_WIN = 1 * MiB;
constexpr size_t WS_WAC = 17 * MiB;
constexpr size_t WS_WOUT = 21 * MiB;
constexpr size_t WS_WGU = 23 * MiB;
constexpr size_t WS_WDN = 34 * MiB;
constexpr size_t WS_ROPE = 40 * MiB;
constexpr size_t WS_U = 42 * MiB;
constexpr size_t WS_V = 74 * MiB, WS_P = 106 * MiB, WS_BG = 138 * MiB, WS_SGA = 170 * MiB, WS_SGC = 202 * MiB;
constexpr size_t WS_T = 74 * MiB;
constexpr size_t WS_MG = 138 * MiB;
constexpr size_t WS_H1B = 170 * MiB;
constexpr size_t WS_HFF = 42 * MiB;
constexpr size_t WS_END = 256 * MiB;
constexpr int LDS_BYTES = 147456;
constexpr int NTHREADS = 512;
constexpr int LDS_MISC = 131072 + 1024;


#define XB_TMO      128
#define XB_XCNT(j)  (256  + 64 * (j))
#define XB_XSUB(j)  (1280 + 64 * (j))
#define XB_XGEN(j)  (2304 + 64 * (j))
#define XB_TOP      3328
#define XB_TOPGEN   3392
#define XCD_BAR_WORDS 3456
#define XB_SPIN_CAP (1u << 18)
__device__ __forceinline__ unsigned xb_ld(unsigned* p)              { return __hip_atomic_load(p, __ATOMIC_RELAXED, __HIP_MEMORY_SCOPE_AGENT); }
__device__ __forceinline__ unsigned xb_add(unsigned* p, unsigned v) { return __hip_atomic_fetch_add(p, v, __ATOMIC_RELAXED, __HIP_MEMORY_SCOPE_AGENT); }
__device__ __forceinline__ unsigned xb_xcc_id() { return (unsigned)__builtin_amdgcn_s_getreg((3 << 11) | 20) & 0xFu; }
#define XB_SPIN(cond, bar) do { unsigned _sp = 0; while (cond) { __builtin_amdgcn_s_sleep(1); \
    if ((++_sp & 255u) == 0u) { if (xb_ld(&(bar)[XB_TMO])) break; if (_sp > XB_SPIN_CAP) { atomicAdd(&(bar)[XB_TMO], 1u); break; } } } } while (0)
struct XcdBarrier { unsigned* bar; unsigned x; volatile LAS unsigned* st; };
__device__ __forceinline__ XcdBarrier xcd_barrier_post(unsigned* bar, volatile LAS unsigned* st) {
    XcdBarrier b; b.bar = bar; b.x = xb_xcc_id(); b.st = st;
    if (threadIdx.x == 0) (void)xb_add(&bar[XB_XCNT(b.x)], 1u);
    return b;
}
__device__ __forceinline__ void xcd_barrier_complete(unsigned* bar, unsigned x, unsigned& nloc, unsigned& nx) {
    const unsigned G = gridDim.x * gridDim.y * gridDim.z;
    unsigned sum, cnt, mine, sp = 0u;
    for (;;) {
        sum = 0u; cnt = 0u; mine = 0u;
#pragma unroll
        for (unsigned j = 0; j < 16; ++j) { const unsigned c = xb_ld(&bar[XB_XCNT(j)]); sum += c; cnt += (c > 0u) ? 1u : 0u; mine = (j == x) ? c : mine; }
        if (sum == G) break;
        __builtin_amdgcn_s_sleep(1);
        if ((++sp & 255u) == 0u) { if (xb_ld(&bar[XB_TMO])) break; if (sp > XB_SPIN_CAP) { atomicAdd(&bar[XB_TMO], 1u); break; } }
    }
    nloc = mine > 0u ? mine : 1u; nx = cnt > 0u ? cnt : 1u;
}
__device__ __forceinline__ void xcd_barrier(const XcdBarrier& b) {
    asm volatile("s_waitcnt vmcnt(0)" ::: "memory");
    __syncthreads();
    if (threadIdx.x == 0) {
        unsigned* bar = b.bar;
        __builtin_amdgcn_s_waitcnt(0);
        unsigned nloc = b.st[0], nx = b.st[1];
        if (nloc == 0u) { xcd_barrier_complete(bar, b.x, nloc, nx); b.st[0] = nloc; b.st[1] = nx; }
        const unsigned old = xb_add(&bar[XB_XSUB(b.x)], 1u);
        const unsigned gen = old / nloc;
        if (old + 1u == (gen + 1u) * nloc) {
            __builtin_amdgcn_fence(__ATOMIC_RELEASE, "agent");
            asm volatile("s_waitcnt vmcnt(0)" ::: "memory");
            const unsigned og = xb_add(&bar[XB_TOP], 1u);
            const unsigned tg = og / nx;
            if (og + 1u == (tg + 1u) * nx) xb_add(&bar[XB_TOPGEN], 1u);
            else XB_SPIN(xb_ld(&bar[XB_TOPGEN]) == tg, bar);
            __builtin_amdgcn_fence(__ATOMIC_ACQUIRE, "agent");
            xb_add(&bar[XB_XGEN(b.x)], 1u);
            asm volatile("s_waitcnt vmcnt(0)" ::: "memory");
        } else {
            XB_SPIN(xb_ld(&bar[XB_XGEN(b.x)]) == gen, bar);
            __builtin_amdgcn_fence(__ATOMIC_ACQUIRE, "agent");
            asm volatile("s_waitcnt vmcnt(0)" ::: "memory");
        }
    }
    __syncthreads();
}

struct Args { const float* in[11]; float* out; unsigned char* ws; int use_cg; int pad; };

__device__ __forceinline__ size_t opq0() { size_t z = 0; asm volatile("" : "+s"(z)); return z; }
__device__ __forceinline__ float wave_sum(float v) {
#pragma unroll
    for (int o = 1; o < 64; o <<= 1) v += __shfl_xor(v, o);
    return v;
}
__device__ __forceinline__ void transpose_item(const float* W, int N, bf16_t* WT, int Kld, int k0, int n0, int dst_row0, const float* kscale, LAS float* scr, int lane) {
#pragma unroll 8
    for (int i = 0; i < 32; ++i) { const int kk = 2 * i + (lane >> 5); float v = W[(size_t)(k0 + kk) * N + n0 + (lane & 31)]; if (kscale) v *= kscale[k0 + kk]; scr[kk * 33 + (lane & 31)] = v; }
    asm volatile("s_waitcnt lgkmcnt(0)" ::: "memory");
    const int c = lane & 7;
#pragma unroll
    for (int j = 0; j < 4; ++j) { const int n = (lane >> 3) + 8 * j; const LAS float* s = scr + (8 * c) * 33 + n;
        u32x4 o; o.x = cvt_pk_bf16(s[0 * 33], s[1 * 33]); o.y = cvt_pk_bf16(s[2 * 33], s[3 * 33]); o.z = cvt_pk_bf16(s[4 * 33], s[5 * 33]); o.w = cvt_pk_bf16(s[6 * 33], s[7 * 33]);
        *(u32x4*)(WT + (size_t)(dst_row0 + n) * Kld + k0 + 8 * c) = o; }
    asm volatile("s_waitcnt lgkmcnt(0)" ::: "memory");
}
__device__ __forceinline__ int map_in(int n0) {
    if (n0 < 3072) return n0;
    if (n0 < 4096) { const int j = n0 - 3072; return 256 * (12 + (j >> 7)) + (j & 127); }
    if (n0 < 5120) return 5120 + (n0 - 4096);
    if (n0 < 6144) { const int j = n0 - 5120; return 256 * (12 + (j >> 7)) + 128 + (j & 127); }
    return n0;
}
__device__ __forceinline__ int map_gu(int n0) { const int j = n0 < DFF ? n0 : n0 - DFF; return 256 * (j >> 7) + (n0 < DFF ? 0 : 128) + (j & 127); }

__global__ void __launch_bounds__(NTHREADS, 2) mk_fwd(Args args) {
    extern __shared__ __attribute__((aligned(16))) unsigned char lds[];
    cg::grid_group grid = cg::this_grid();
    { volatile LAS unsigned* st0 = (volatile LAS unsigned*)((LAS unsigned char*)lds + LDS_MISC); if (threadIdx.x < 2) st0[threadIdx.x] = 0u; __syncthreads(); }
    const XcdBarrier xbar = xcd_barrier_post((unsigned*)(args.ws + WS_BAR), (volatile LAS unsigned*)((LAS unsigned char*)lds + LDS_MISC));
    if (args.use_cg) grid.sync();
#define GRID_BAR() xcd_barrier(xbar)
    const int G = gridDim.x, bx = blockIdx.x;
#define TIDS() int tid = threadIdx.x; asm volatile("" : "+v"(tid)); const int lane = tid & 63, wave = __builtin_amdgcn_readfirstlane(tid >> 6); (void)lane; (void)wave
    const int vcu = (G % 8 == 0) ? (bx % 8) * (G / 8) + bx / 8 : bx;
#define OPQ(p) ((p) + opq0())
#define WSP(T, off) ((T*)(ws + (off)))
    LAS unsigned char* ldsl = (LAS unsigned char*)lds;

    {
        TIDS();
        unsigned char* ws = OPQ(args.ws);
        const float* x = OPQ(args.in[0]); const float* g_mix = OPQ(args.in[1]); const float* w_in = OPQ(args.in[2]); const float* w_a = OPQ(args.in[4]); const float* w_c = OPQ(args.in[5]);
        const float* w_out = OPQ(args.in[6]); const float* g_ffn = OPQ(args.in[7]); const float* w_gu = OPQ(args.in[8]); const float* w_dn = OPQ(args.in[9]);
        bf16_t* WIN = WSP(bf16_t, WS_WIN); bf16_t* WAC = WSP(bf16_t, WS_WAC); bf16_t* WOUT = WSP(bf16_t, WS_WOUT); bf16_t* WGU = WSP(bf16_t, WS_WGU); bf16_t* WDN = WSP(bf16_t, WS_WDN);
        float* ROPEC = WSP(float, WS_ROPE); float* ROPES = ROPEC + SEQ * 16; bf16_t* U = WSP(bf16_t, WS_U);
        LAS float* scr = (LAS float*)(ldsl + wave * 16384);
        const int gw = vcu * 8 + wave, NGW = G * 8;
        constexpr int I_IN = 16 * 256, I_SQ = 16 * 32, I_GU = 16 * 176, I_DN = 44 * 32;
        constexpr int NITEMS = I_IN + 3 * I_SQ + I_GU + I_DN;
        for (int it = gw; it < NITEMS; it += NGW) {
            int r = it;
            if (r < I_IN) { const int kb = r >> 8, nb = r & 255; transpose_item(w_in, INW, WIN, DM, 64 * kb, 32 * nb, map_in(32 * nb), nullptr, scr, lane); continue; } r -= I_IN;
            if (r < I_SQ) { const int kb = r >> 5, nb = r & 31; transpose_item(w_a, DM, WAC, DM, 64 * kb, 32 * nb, 32 * nb, nullptr, scr, lane); continue; } r -= I_SQ;
            if (r < I_SQ) { const int kb = r >> 5, nb = r & 31; transpose_item(w_c, DM, WAC, DM, 64 * kb, 32 * nb, 1024 + 32 * nb, nullptr, scr, lane); continue; } r -= I_SQ;
            if (r < I_SQ) { const int kb = r >> 5, nb = r & 31; transpose_item(w_out, DM, WOUT, DM, 64 * kb, 32 * nb, 32 * nb, nullptr, scr, lane); continue; } r -= I_SQ;
            if (r < I_GU) { const int kb = r / 176, nb = r % 176; transpose_item(w_gu, 2 * DFF, WGU, DM, 64 * kb, 32 * nb, map_gu(32 * nb), g_ffn, scr, lane); continue; } r -= I_GU;
            { const int kb = r >> 5, nb = r & 31; transpose_item(w_dn, DM, WDN, DFF, 64 * kb, 32 * nb, 32 * nb, nullptr, scr, lane); }
        }
        for (int m = gw; m < MTOK; m += NGW) {
            const f32x4* xr = (const f32x4*)(x + (size_t)m * DM) + lane; const f32x4* gr = (const f32x4*)g_mix + lane;
            f32x4 v[4]; float s = 0.f;
#pragma unroll
            for (int j = 0; j < 4; ++j) { v[j] = xr[64 * j]; s += (v[j].x * v[j].x + v[j].y * v[j].y) + (v[j].z * v[j].z + v[j].w * v[j].w); }
            const float rstd = 1.0f / sqrtf(wave_sum(s) * (1.0f / DM) + EPS);
            u32x2* o8 = (u32x2*)(U + (size_t)m * DM) + lane;
#pragma unroll
            for (int j = 0; j < 4; ++j) { const f32x4 gg = gr[64 * j]; u32x2 w; w.x = cvt_pk_bf16(v[j].x * rstd * gg.x, v[j].y * rstd * gg.y); w.y = cvt_pk_bf16(v[j].z * rstd * gg.z, v[j].w * rstd * gg.w); o8[64 * j] = w; }
        }
        for (int idx = (vcu * NTHREADS + tid); idx < SEQ * 16; idx += G * NTHREADS) {
            const int pos = idx >> 4, i = idx & 15;
            const double f = exp2(-(double)i * (18.931568569324174 / 16.0));
            const double a = (double)pos * f;
            ROPEC[idx] = (float)cos(a); ROPES[idx] = (float)sin(a);
        }
    }
    GRID_BAR();

    {
        unsigned char* ws = OPQ(args.ws); unsigned char* outb = (unsigned char*)OPQ(args.out);
        float* ROPEC = WSP(float, WS_ROPE);
        pg8::Gemm g{WSP(bf16_t, WS_U), WSP(bf16_t, WS_U), 1 << 30, WSP(bf16_t, WS_WIN), MTOK, INW, DM}; pg8::StaticOrder S; S.init(MTOK, INW, G, bx);
        pg8::EpiIn E{(bf16_t*)outb, (bf16_t*)(outb + 32 * MiB), WSP(bf16_t, WS_V), WSP(bf16_t, WS_P), WSP(bf16_t, WS_BG), WSP(bf16_t, WS_SGA), WSP(bf16_t, WS_SGC), WSP(float, WS_KM), ROPEC, ROPEC + SEQ * 16};
        pg8::gemm_phase<pg8::EpiIn, pg8::StaticOrder, true, true>(ldsl, g, S, E);
    }
    GRID_BAR();

    {
        TIDS();
        unsigned char* ws = OPQ(args.ws); unsigned char* outb = (unsigned char*)OPQ(args.out); const float* conv_w = OPQ(args.in[3]);
        bf16_t* PB = WSP(bf16_t, WS_P); bf16_t* BG = WSP(bf16_t, WS_BG); bf16_t* CZ = WSP(bf16_t, WS_U);
        bf16_t* QB_ = (bf16_t*)outb; bf16_t* KB_ = (bf16_t*)(outb + 32 * MiB); bf16_t* VB_ = WSP(bf16_t, WS_V); float* KM = WSP(float, WS_KM);
        for (int w = vcu * NTHREADS + tid; w < 128 * (MTOK / 16); w += G * NTHREADS) {
            const int cgp = w & 127, rc = w >> 7, c0 = cgp * 8, row0 = rc * 16;
            f32x4 w0a = *(const f32x4*)(conv_w + c0), w0b = *(const f32x4*)(conv_w + c0 + 4);
            f32x4 w1a = *(const f32x4*)(conv_w + DM + c0), w1b = *(const f32x4*)(conv_w + DM + c0 + 4);
            f32x4 w2a = *(const f32x4*)(conv_w + 2 * DM + c0), w2b = *(const f32x4*)(conv_w + 2 * DM + c0 + 4);
            f32x4 m2a = {0.f, 0.f, 0.f, 0.f}, m2b = m2a, m1a = m2a, m1b = m2a;
            if ((row0 & (SEQ - 1)) != 0) { unpack8(*(const u32x4*)(PB + (size_t)(row0 - 2) * DM + c0), m2a, m2b); unpack8(*(const u32x4*)(PB + (size_t)(row0 - 1) * DM + c0), m1a, m1b); }
#pragma unroll 4
            for (int r = 0; r < 16; ++r) { const size_t o = (size_t)(row0 + r) * DM + c0;
                f32x4 pa, pb, ba, bb; unpack8(*(const u32x4*)(PB + o), pa, pb); unpack8(*(const u32x4*)(BG + o), ba, bb);
                const f32x4 ya = ba * (w0a * m2a + w1a * m1a + w2a * pa), yb = bb * (w0b * m2b + w1b * m1b + w2b * pb);
                *(u32x4*)(CZ + o) = pack8u(ya, yb);
                m2a = m1a; m2b = m1b; m1a = pa; m1b = pb; }
        }
        const int nitems = (256 - vcu + G - 1) / G;
        if (vcu < 256) {
            const int nblocks = 2 * nitems;
            auto mkref = [&](int k) { const int item = vcu + (k >> 1) * G, bh = item >> 4, s = item & 15, b = bh >> 3, h = bh & 7;
                att::BlockRef r; const size_t base = (size_t)b * SEQ * DM + h * HD;
                r.Q = QB_ + base; r.K = KB_ + base; r.V = VB_ + base; r.O = QB_ + base; r.KM = KM + (size_t)bh * NKB * HD; r.qb = (k & 1) ? 31 - s : s; return r; };
            att::Seam S; att::BlockRef cur = mkref(0);
            att::moba_prime(cur, (char*)lds, S);
            for (int k = 0; k < nblocks; ++k) {
                const att::BlockRef nxt = (k + 1 < nblocks) ? mkref(k + 1) : cur;
                att::moba_block(cur, nxt, (char*)lds, S);
                cur = nxt;
            }
        }
    }
    GRID_BAR();

    {
        unsigned char* ws = OPQ(args.ws); unsigned char* outb = (unsigned char*)OPQ(args.out);
        pg8::Gemm g{(bf16_t*)outb, WSP(bf16_t, WS_U), 64, WSP(bf16_t, WS_WAC), 2 * MTOK, 2 * DM, DM}; pg8::BranchOrder S; S.s.init(MTOK, DM, G, bx);
        pg8::EpiBranch E{WSP(bf16_t, WS_SGA), WSP(bf16_t, WS_SGC), WSP(float, WS_T), WSP(bf16_t, WS_MG)};
        pg8::gemm_phase<pg8::EpiBranch, pg8::BranchOrder, true, true>(ldsl, g, S, E);
    }
    GRID_BAR();

    {
        unsigned char* ws = OPQ(args.ws);
        pg8::Gemm g{WSP(bf16_t, WS_MG), WSP(bf16_t, WS_MG), 1 << 30, WSP(bf16_t, WS_WOUT), MTOK, DM, DM}; pg8::StaticOrder S; S.init(MTOK, DM, G, bx);
        pg8::EpiH1 E{OPQ(args.in[0]), OPQ(args.out), WSP(bf16_t, WS_H1B), WSP(float, WS_SSQ1)};
        pg8::gemm_phase<pg8::EpiH1, pg8::StaticOrder, true, true>(ldsl, g, S, E);
    }
    GRID_BAR();

    {
        unsigned char* ws = OPQ(args.ws);
        pg8::Gemm g{WSP(bf16_t, WS_H1B), WSP(bf16_t, WS_H1B), 1 << 30, WSP(bf16_t, WS_WGU), MTOK, 2 * DFF, DM}; pg8::StaticOrder S; S.init(MTOK, 2 * DFF, G, bx);
        pg8::EpiSwiglu E{WSP(float, WS_SSQ1), WSP(bf16_t, WS_HFF)};
        pg8::gemm_phase<pg8::EpiSwiglu, pg8::StaticOrder, true, true>(ldsl, g, S, E);
    }
    GRID_BAR();

    {
        unsigned char* ws = OPQ(args.ws);
        pg8::Gemm g{WSP(bf16_t, WS_HFF), WSP(bf16_t, WS_HFF), 1 << 30, WSP(bf16_t, WS_WDN), MTOK, DM, DFF}; pg8::StaticOrder S; S.init(MTOK, DM, G, bx);
        pg8::EpiDown E{OPQ(args.out), WSP(float, WS_SSQ2)};
        pg8::gemm_phase<pg8::EpiDown, pg8::StaticOrder, true, true>(ldsl, g, S, E);
    }
    GRID_BAR();

    {
        TIDS();
        unsigned char* ws = OPQ(args.ws); float* out = OPQ(args.out); const float* g_final = OPQ(args.in[10]); const float* SSQ2 = WSP(float, WS_SSQ2);
        const int gw = vcu * 8 + wave, NGW = G * 8;
        for (int m = gw; m < MTOK; m += NGW) {
            f32x4* xr = (f32x4*)(out + (size_t)m * DM) + lane; const f32x4* gr = (const f32x4*)g_final + lane;
            const float rstd = 1.0f / sqrtf(SSQ2[m] * (1.0f / DM) + EPS);
#pragma unroll
            for (int j = 0; j < 4; ++j) { const f32x4 v = xr[64 * j], gg = gr[64 * j]; xr[64 * j] = v * rstd * gg; }
        }
    }
}

extern "C" void kernel_launch(void* const* d_in, const int* in_sizes, int n_in, void* d_out, int out_size, void* d_ws, size_t ws_size, hipStream_t stream) {
    static int grid = 0;
    if (grid == 0) {
        if (n_in != 11 || out_size != MTOK * DM || ws_size < WS_END) { fprintf(stderr, "kernel_launch: unexpected shapes (n_in %d out %d ws %zu)\n", n_in, out_size, ws_size); grid = -1; return; }
        int dev = 0, cus = 0, per_cu = 0;
        (void)hipGetDevice(&dev); (void)hipDeviceGetAttribute(&cus, hipDeviceAttributeMultiprocessorCount, dev);
        if (hipFuncSetAttribute((const void*)mk_fwd, hipFuncAttributeMaxDynamicSharedMemorySize, LDS_BYTES) != hipSuccess) { fprintf(stderr, "kernel_launch: hipFuncSetAttribute failed\n"); grid = -1; return; }
        if (hipOccupancyMaxActiveBlocksPerMultiprocessor(&per_cu, (const void*)mk_fwd, NTHREADS, LDS_BYTES) != hipSuccess || per_cu < 1) { fprintf(stderr, "kernel_launch: occupancy query failed (%d)\n", per_cu); grid = -1; return; }
        grid = cus * per_cu;
        if (grid > 256) grid = 256;
        grid &= ~7;
        fprintf(stderr, "kernel_launch: cus %d per_cu %d grid %d\n", cus, per_cu, grid);
    }
    if (grid <= 0) return;
    (void)hipMemsetAsync((char*)d_ws + WS_CTL, 0, CTL_ZERO_BYTES, stream);
    Args a{};
    for (int i = 0; i < 11; ++i) a.in[i] = (const float*)d_in[i];
    a.out = (float*)d_out; a.ws = (unsigned char*)d_ws; a.use_cg = 0; a.pad = 0;
    void* kargs[] = {&a};
    hipError_t e = hipLaunchCooperativeKernel((const void*)mk_fwd, dim3(grid), dim3(NTHREADS), kargs, LDS_BYTES, stream);
    if (e != hipSuccess) fprintf(stderr, "kernel_launch: cooperative launch failed: %s (grid %d)\n", hipGetErrorString(e), grid);
}
```

```cpp
#include <hip/hip_runtime.h>
#include <hip/hip_cooperative_groups.h>
#include <cstdio>
#include <cstdint>
namespace cg = cooperative_groups;

#define LAS __attribute__((address_space(3)))
typedef unsigned short bf16_t;
typedef short bf16x8 __attribute__((ext_vector_type(8)));
typedef short s16x4 __attribute__((ext_vector_type(4)));
typedef float f32x2 __attribute__((ext_vector_type(2)));
typedef float f32x4 __attribute__((ext_vector_type(4)));
typedef float f32x16 __attribute__((ext_vector_type(16)));
typedef unsigned u32x2 __attribute__((ext_vector_type(2)));
typedef unsigned u32x4 __attribute__((ext_vector_type(4)));

constexpr int BATCH = 2, SEQ = 8192, DM = 1024, MTOK = BATCH * SEQ, NHEAD = 8, HD = 128, NKB = SEQ / 256, DFF = 2816, INW = 8192;
constexpr float EPS = 1e-6f;
constexpr float QSCALE = 0.08838834764831845f * 1.4426950408889634f;

__device__ __forceinline__ unsigned cvt_pk_bf16(float lo, float hi) { unsigned r; asm volatile("v_cvt_pk_bf16_f32 %0, %1, %2" : "=v"(r) : "v"(lo), "v"(hi)); return r; }
__device__ __forceinline__ u32x4 pack8u(f32x4 a, f32x4 b) { u32x4 w; w.x = cvt_pk_bf16(a[0], a[1]); w.y = cvt_pk_bf16(a[2], a[3]); w.z = cvt_pk_bf16(b[0], b[1]); w.w = cvt_pk_bf16(b[2], b[3]); return w; }
__device__ __forceinline__ float bf_lo(unsigned w) { return __uint_as_float(w << 16); }
__device__ __forceinline__ float bf_hi(unsigned w) { return __uint_as_float(w & 0xffff0000u); }
__device__ __forceinline__ void unpack8(u32x4 w, f32x4& a, f32x4& b) { a = (f32x4){bf_lo(w.x), bf_hi(w.x), bf_lo(w.y), bf_hi(w.y)}; b = (f32x4){bf_lo(w.z), bf_hi(w.z), bf_lo(w.w), bf_hi(w.w)}; }
__device__ __forceinline__ float sigmoidf_(float x) { return 1.0f / (1.0f + __expf(-x)); }

namespace pg8 {
constexpr int BM = 256, BK = 64, HALF = 128, HTB = HALF * BK * 2, STAGE_BYTES = 8 * HTB, NXCD = 8, WGM = 8;
__host__ __device__ __forceinline__ int lds_byte(int r, int c) { const int st = (r >> 4) * 2 + (c >> 5), rr = r & 15, cc = c & 31, ob = rr * 64 + cc * 2; return st * 1024 + (ob ^ (((ob >> 9) & 1) << 5)); }
__host__ __device__ __forceinline__ void stage_rc(int b, int& R, int& C) { const int st = b / 1024, sb = b % 1024, swz = sb ^ (((sb >> 9) & 1) << 5); R = (st >> 1) * 16 + swz / 64; C = (st & 1) * 32 + (swz % 64) / 2; }
__host__ __device__ __forceinline__ int perm32(int rho) { const int n = rho >> 4, i = rho & 15; return 8 * (i >> 2) + 4 * n + (i & 3); }

struct Unit { int pm, pn; };
struct Gemm { const bf16_t* A; const bf16_t* A2; int pmsplit; const bf16_t* Bt; int M, N, K; };

struct StaticOrder {
    int nM, nN, nwg, G, c;
    __host__ __device__ void init(int M, int N, int G_, int c_) { nM = M / BM; nN = N / BM; nwg = nM * nN; G = G_; c = c_; }
    __host__ __device__ bool next(int i, Unit& u) const {
        const long L = (long)i * G + c; if (L >= nwg) return false;
        int wgid = (int)L; { const int q = nwg / NXCD, r = nwg % NXCD, xcd = wgid % NXCD, off = wgid / NXCD; wgid = (xcd < r ? xcd * (q + 1) : r * (q + 1) + (xcd - r) * q) + off; }
        const int nig = WGM * nN, gid = wgid / nig, fm = gid * WGM, gsz = (nM - fm) < WGM ? (nM - fm) : WGM;
        u.pm = fm + ((wgid % nig) % gsz); u.pn = (wgid % nig) / gsz; return true;
    }
    __device__ __forceinline__ void a_ready(const Unit&) const {}
    __device__ __forceinline__ void done(const Unit&) const {}
};
struct BranchOrder {
    StaticOrder s;
    __device__ bool next(int i, Unit& u) const { if (!s.next(i >> 1, u)) return false; if (i & 1) { u.pm += 64; u.pn += 4; } return true; }
    __device__ __forceinline__ void a_ready(const Unit&) const {}
    __device__ __forceinline__ void done(const Unit&) const {}
};

template <class Epi, class Sched, bool ALIGN_EPI = false, bool SP2 = false>
__device__ __forceinline__ void gemm_phase(LAS unsigned char* lds, const Gemm g, const Sched& S, const Epi& E) {
    int tid = threadIdx.x; asm volatile("" : "+v"(tid));
    const int wid = __builtin_amdgcn_readfirstlane(tid >> 6), lane = tid & 63, wr = wid >> 2, wc = wid & 3, fr = lane & 15, fq = lane >> 4;
    const int K = g.K, nt = K / BK;
    unsigned voffA[2], voffB[2];
#pragma unroll
    for (int i = 0; i < 2; ++i) { int R, C; stage_rc(tid * 16 + i * 8192, R, C); const int Rb = Epi::PERM ? ((R & ~31) + perm32(R & 31)) : R;
        voffA[i] = (unsigned)(R * K + C) * 2u; voffB[i] = (unsigned)(Rb * K + C) * 2u; }
    const size_t kstep = (size_t)(BK * 2);
    const size_t hstep = (size_t)HALF * K * 2;
    const size_t tstep = 2 * hstep;
    const unsigned ldsw = (unsigned)wid * 1024u;
    const int aoff = lds_byte(wr * 64 + fr, fq * 8), boff = lds_byte(wc * 32 + fr, fq * 8);
#define PG8_APTR(pm_) ((pm_) < g.pmsplit ? (const char*)g.A + (size_t)(pm_) * tstep : (const char*)g.A2 + (size_t)((pm_) - g.pmsplit) * tstep)
#define PG8_SA(b, h) (((b) * 2 + (h)) * HTB)
#define PG8_SB(b, h) ((4 + (b) * 2 + (h)) * HTB)
#define PG8_STAGE(bufoff, gbase, voff) do { _Pragma("unroll") for (int _i = 0; _i < 2; ++_i) \
        __builtin_amdgcn_global_load_lds((const unsigned*)((const char*)(gbase) + (voff)[_i]), (LAS unsigned*)(lds + (bufoff) + ldsw + _i * 8192), 16, 0, 0); } while (0)
#define PG8_LDA(dst, b, h) do { _Pragma("unroll") for (int m = 0; m < 4; ++m) _Pragma("unroll") for (int k = 0; k < 2; ++k) dst[m][k] = *(const LAS bf16x8*)(lds + PG8_SA(b, h) + aoff + m * 2048 + k * 1024); } while (0)
#define PG8_LDB(dst, b, h) do { _Pragma("unroll") for (int n = 0; n < 2; ++n) _Pragma("unroll") for (int k = 0; k < 2; ++k) dst[n][k] = *(const LAS bf16x8*)(lds + PG8_SB(b, h) + boff + n * 2048 + k * 1024); } while (0)
#define PG8_MMA(ai, bj, At, Bt) do { __builtin_amdgcn_s_setprio(1); _Pragma("unroll") for (int m = 0; m < 4; ++m) _Pragma("unroll") for (int n = 0; n < 2; ++n) _Pragma("unroll") for (int k = 0; k < 2; ++k) \
        acc[ai][bj][m][n] = __builtin_amdgcn_mfma_f32_16x16x32_bf16(Bt[n][k], At[m][k], acc[ai][bj][m][n], 0, 0, 0); __builtin_amdgcn_s_setprio(0); } while (0)
#define PG8_WAIT_V(n) asm volatile("s_waitcnt vmcnt(" #n ")" ::: "memory")
#define PG8_WAIT_L(n) asm volatile("s_waitcnt lgkmcnt(" #n ")" ::: "memory")
#define PG8_BAR __builtin_amdgcn_s_barrier()
#define PG8_SCHED __builtin_amdgcn_sched_barrier(0)
    Unit cur, nxt; int ui = 0;
    if (!S.next(0, cur)) return;
    f32x4 acc[2][2][4][2];
#pragma unroll
    for (int a = 0; a < 2; ++a)
#pragma unroll
        for (int b = 0; b < 2; ++b)
#pragma unroll
            for (int m = 0; m < 4; ++m)
#pragma unroll
                for (int n = 0; n < 2; ++n) acc[a][b][m][n] = (f32x4){0.f, 0.f, 0.f, 0.f};
    bf16x8 At[4][2], B0[2][2], B1[2][2];
    const char* cA = PG8_APTR(cur.pm); const char* cB = (const char*)g.Bt + (size_t)cur.pn * tstep;
    S.a_ready(cur);
    if constexpr (SP2) {
        PG8_STAGE(PG8_SB(0, 0), cB, voffB); PG8_STAGE(PG8_SB(0, 1), cB + hstep, voffB); PG8_STAGE(PG8_SA(0, 0), cA, voffA); PG8_STAGE(PG8_SA(0, 1), cA + hstep, voffA);
        if (wr == 1) PG8_BAR;
        PG8_WAIT_V(2); PG8_BAR;
        PG8_STAGE(PG8_SB(1, 0), cB + kstep, voffB); PG8_STAGE(PG8_SA(1, 0), cA + kstep, voffA); PG8_STAGE(PG8_SB(1, 1), cB + hstep + kstep, voffB);
        PG8_WAIT_V(6); PG8_BAR;
    } else {
        PG8_STAGE(PG8_SB(0, 0), cB, voffB); PG8_STAGE(PG8_SA(0, 0), cA, voffA); PG8_STAGE(PG8_SB(0, 1), cB + hstep, voffB); PG8_STAGE(PG8_SA(0, 1), cA + hstep, voffA);
        if (wr == 1) PG8_BAR;
        PG8_WAIT_V(4); PG8_BAR;
        PG8_STAGE(PG8_SB(1, 0), cB + kstep, voffB); PG8_STAGE(PG8_SA(1, 0), cA + kstep, voffA); PG8_STAGE(PG8_SB(1, 1), cB + hstep + kstep, voffB);
        PG8_WAIT_V(6); PG8_BAR;
    }
    for (;;) {
        const bool has_next = S.next(ui + 1, nxt);
        const char* nA = has_next ? PG8_APTR(nxt.pm) : cA; const char* nB = has_next ? (const char*)g.Bt + (size_t)nxt.pn * tstep : cB;
        for (int t = 0; t < nt; t += 2) {
            const bool last = (t == nt - 2);
            const char* a1 = cA + (size_t)(t + 1) * kstep;
            const char* a2 = last ? nA : cA + (size_t)(t + 2) * kstep; const char* b2 = last ? nB : cB + (size_t)(t + 2) * kstep;
            const char* a3 = a2 + kstep; const char* b3 = b2 + kstep;
            if (last && has_next) S.a_ready(nxt);
            if constexpr (SP2) {
            PG8_LDB(B0, 0, 0); PG8_LDB(B1, 0, 1); PG8_SCHED; PG8_LDA(At, 0, 0); PG8_STAGE(PG8_SA(1, 1), a1 + hstep, voffA);
            PG8_WAIT_V(8); PG8_WAIT_L(0); PG8_BAR; PG8_MMA(0, 0, At, B0); PG8_MMA(0, 1, At, B1); PG8_BAR; PG8_SCHED;
            PG8_LDA(At, 0, 1); PG8_STAGE(PG8_SB(0, 0), b2, voffB); PG8_STAGE(PG8_SB(0, 1), b2 + hstep, voffB); PG8_STAGE(PG8_SA(0, 0), a2, voffA);
            PG8_WAIT_V(8); PG8_WAIT_L(0); PG8_BAR; PG8_MMA(1, 0, At, B0); PG8_MMA(1, 1, At, B1); PG8_BAR; PG8_SCHED;
            PG8_LDB(B0, 1, 0); PG8_LDB(B1, 1, 1); PG8_SCHED; PG8_LDA(At, 1, 0); PG8_STAGE(PG8_SA(0, 1), a2 + hstep, voffA);
            PG8_WAIT_V(8); PG8_WAIT_L(0); PG8_BAR; PG8_MMA(0, 0, At, B0); PG8_MMA(0, 1, At, B1); PG8_BAR; PG8_SCHED;
            PG8_LDA(At, 1, 1); PG8_STAGE(PG8_SB(1, 0), b3, voffB); PG8_STAGE(PG8_SB(1, 1), b3 + hstep, voffB); PG8_STAGE(PG8_SA(1, 0), a3, voffA);
            PG8_WAIT_V(8); PG8_WAIT_L(0); PG8_BAR; PG8_MMA(1, 0, At, B0); PG8_MMA(1, 1, At, B1); PG8_BAR; PG8_SCHED;
            } else {
            PG8_LDB(B0, 0, 0); PG8_SCHED; PG8_LDA(At, 0, 0); PG8_STAGE(PG8_SA(1, 1), a1 + hstep, voffA);
            PG8_WAIT_L(8); PG8_BAR; PG8_WAIT_L(0); PG8_MMA(0, 0, At, B0); PG8_BAR; PG8_SCHED;
            PG8_LDB(B1, 0, 1); PG8_STAGE(PG8_SB(0, 0), b2, voffB);
            PG8_BAR; PG8_WAIT_L(0); PG8_MMA(0, 1, At, B1); PG8_BAR;
            PG8_LDA(At, 0, 1); PG8_STAGE(PG8_SA(0, 0), a2, voffA);
            PG8_BAR; PG8_WAIT_L(0); PG8_MMA(1, 0, At, B0); PG8_BAR; PG8_SCHED;
            PG8_STAGE(PG8_SB(0, 1), b2 + hstep, voffB);
            PG8_WAIT_V(6); PG8_BAR; PG8_MMA(1, 1, At, B1); PG8_BAR;
            PG8_LDB(B0, 1, 0); PG8_SCHED; PG8_LDA(At, 1, 0); PG8_STAGE(PG8_SA(0, 1), a2 + hstep, voffA);
            PG8_WAIT_L(8); PG8_BAR; PG8_WAIT_L(0); PG8_MMA(0, 0, At, B0); PG8_BAR; PG8_SCHED;
            PG8_LDB(B1, 1, 1); PG8_STAGE(PG8_SB(1, 0), b3, voffB);
            PG8_BAR; PG8_WAIT_L(0); PG8_MMA(0, 1, At, B1); PG8_BAR;
            PG8_LDA(At, 1, 1); PG8_STAGE(PG8_SA(1, 0), a3, voffA);
            PG8_BAR; PG8_WAIT_L(0); PG8_MMA(1, 0, At, B0); PG8_BAR; PG8_SCHED;
            PG8_STAGE(PG8_SB(1, 1), b3 + hstep, voffB);
            PG8_WAIT_V(6); PG8_BAR; PG8_MMA(1, 1, At, B1); PG8_BAR;
            }
        }
        if constexpr (ALIGN_EPI) { if (wr == 0) PG8_BAR; }
        E(acc, cur, wr, wc, fr, fq); S.done(cur);
        if (!has_next) break;
#pragma unroll
        for (int a = 0; a < 2; ++a)
#pragma unroll
            for (int b = 0; b < 2; ++b)
#pragma unroll
                for (int m = 0; m < 4; ++m)
#pragma unroll
                    for (int n = 0; n < 2; ++n) acc[a][b][m][n] = (f32x4){0.f, 0.f, 0.f, 0.f};
        cur = nxt; cA = nA; cB = nB; ++ui;
        if constexpr (ALIGN_EPI) { if (wr == 1) PG8_BAR; }
    }
    PG8_WAIT_V(0);
    if constexpr (!ALIGN_EPI) { if (wr == 0) PG8_BAR; }
    PG8_BAR;
#undef PG8_APTR
#undef PG8_SA
#undef PG8_SB
#undef PG8_STAGE
#undef PG8_LDA
#undef PG8_LDB
#undef PG8_MMA
#undef PG8_WAIT_V
#undef PG8_WAIT_L
#undef PG8_BAR
#undef PG8_SCHED
}

struct EpiIn {
    static constexpr bool PERM = true;
    bf16_t *Q, *K, *V, *P, *BG, *SGA, *SGC; float* KM; const float* RC; const float* RS;
    __device__ __forceinline__ void operator()(const f32x4 (&acc)[2][2][4][2], const Unit& u, int wr, int wc, int fr, int fq) const {
        const int pn = u.pn, row0 = u.pm * BM + wr * 64 + fr, cw = wc * 32 + 8 * fq;
        if (pn < 8) {
            const bool isq = pn < 4; bf16_t* O = (isq ? Q : K) + (pn & 3) * 256 + cw;
            const float sgn = fq < 2 ? -1.f : 1.f;
            float ks[2][2][4];
#pragma unroll
            for (int bj = 0; bj < 2; ++bj)
#pragma unroll
                for (int n = 0; n < 2; ++n)
#pragma unroll
                    for (int e = 0; e < 4; ++e) ks[bj][n][e] = 0.f;
#pragma unroll
            for (int ai = 0; ai < 2; ++ai)
#pragma unroll
                for (int m = 0; m < 4; ++m) {
                    const int row = row0 + ai * HALF + m * 16, pos = row & (SEQ - 1);
                    f32x4 c0 = {1.f, 1.f, 1.f, 1.f}, c1 = c0, s0 = {0.f, 0.f, 0.f, 0.f}, s1 = s0;
                    if (wc == 0) { const float* rc = RC + pos * 16 + 8 * (fq & 1); const float* rs = RS + pos * 16 + 8 * (fq & 1);
                        c0 = *(const f32x4*)rc; c1 = *(const f32x4*)(rc + 4); s0 = *(const f32x4*)rs; s1 = *(const f32x4*)(rs + 4); }
#pragma unroll
                    for (int bj = 0; bj < 2; ++bj) {
                        f32x4 v0 = acc[ai][bj][m][0], v1 = acc[ai][bj][m][1];
                        if (wc == 0) {
                            f32x4 p0, p1;
#pragma unroll
                            for (int e = 0; e < 4; ++e) { p0[e] = __shfl_xor(v0[e], 32); p1[e] = __shfl_xor(v1[e], 32); }
                            v0 = v0 * c0 + (p0 * s0) * sgn; v1 = v1 * c1 + (p1 * s1) * sgn;
                        }
                        if (isq) { v0 = v0 * QSCALE; v1 = v1 * QSCALE; }
                        else {
#pragma unroll
                            for (int e = 0; e < 4; ++e) { ks[bj][0][e] += v0[e]; ks[bj][1][e] += v1[e]; } }
                        *(u32x4*)(O + (size_t)row * DM + bj * HALF) = pack8u(v0, v1);
                    }
                }
            if (!isq) {
                float* kmb = KM + ((size_t)((u.pm >> 5) * NHEAD + 2 * (pn & 3)) * NKB + (u.pm & 31)) * HD + cw;
#pragma unroll
                for (int bj = 0; bj < 2; ++bj)
#pragma unroll
                    for (int n = 0; n < 2; ++n)
#pragma unroll
                        for (int e = 0; e < 4; ++e) { float v = ks[bj][n][e];
                            v += __shfl_xor(v, 1); v += __shfl_xor(v, 2); v += __shfl_xor(v, 4); v += __shfl_xor(v, 8);
                            if (fr == 0) atomicAdd(kmb + (size_t)bj * NKB * HD + 4 * n + e, v); }
            }
        } else if (pn < 12 || (pn >= 20 && pn < 24)) {
            bf16_t* O = (pn < 12 ? V + (pn - 8) * 256 : BG + (pn - 20) * 256) + cw;
#pragma unroll
            for (int ai = 0; ai < 2; ++ai)
#pragma unroll
                for (int m = 0; m < 4; ++m) { const int row = row0 + ai * HALF + m * 16;
#pragma unroll
                    for (int bj = 0; bj < 2; ++bj) *(u32x4*)(O + (size_t)row * DM + bj * HALF) = pack8u(acc[ai][bj][m][0], acc[ai][bj][m][1]); }
        } else if (pn < 20) {
            bf16_t* O = P + (pn - 12) * 128 + cw;
#pragma unroll
            for (int ai = 0; ai < 2; ++ai)
#pragma unroll
                for (int m = 0; m < 4; ++m) { const int row = row0 + ai * HALF + m * 16;
                    *(u32x4*)(O + (size_t)row * DM) = pack8u(acc[ai][0][m][0] * acc[ai][1][m][0], acc[ai][0][m][1] * acc[ai][1][m][1]); }
        } else {
            bf16_t* O = (pn < 28 ? SGA + (pn - 24) * 256 : SGC + (pn - 28) * 256) + cw;
#pragma unroll
            for (int ai = 0; ai < 2; ++ai)
#pragma unroll
                for (int m = 0; m < 4; ++m) { const int row = row0 + ai * HALF + m * 16;
#pragma unroll
                    for (int bj = 0; bj < 2; ++bj) { f32x4 v0 = acc[ai][bj][m][0], v1 = acc[ai][bj][m][1];
#pragma unroll
                        for (int e = 0; e < 4; ++e) { v0[e] = sigmoidf_(v0[e]); v1[e] = sigmoidf_(v1[e]); }
                        *(u32x4*)(O + (size_t)row * DM + bj * HALF) = pack8u(v0, v1); } }
        }
    }
};
struct EpiBranch {
    static constexpr bool PERM = true;
    const bf16_t *SGA, *SGC; float* T; bf16_t* MG;
    __device__ __forceinline__ void operator()(const f32x4 (&acc)[2][2][4][2], const Unit& u, int wr, int wc, int fr, int fq) const {
        const int type = u.pm >> 6, pm = u.pm & 63, pn = u.pn & 3;
        const int row0 = pm * BM + wr * 64 + fr, col0 = pn * BM + wc * 32 + 8 * fq;
        const bf16_t* SG = type ? SGC : SGA;
#pragma unroll
        for (int ai = 0; ai < 2; ++ai)
#pragma unroll
            for (int m = 0; m < 4; ++m) { const size_t ro = (size_t)(row0 + ai * HALF + m * 16) * DM + col0;
#pragma unroll
                for (int bj = 0; bj < 2; ++bj) { const size_t o = ro + bj * HALF;
                    f32x4 g0, g1; unpack8(*(const u32x4*)(SG + o), g0, g1);
                    f32x4 v0 = acc[ai][bj][m][0] * g0, v1 = acc[ai][bj][m][1] * g1;
                    if (type == 0) { *(f32x4*)(T + o) = v0; *(f32x4*)(T + o + 4) = v1; }
                    else { v0 = v0 + *(const f32x4*)(T + o); v1 = v1 + *(const f32x4*)(T + o + 4); *(u32x4*)(MG + o) = pack8u(v0, v1); } } }
    }
};
struct EpiH1 {
    static constexpr bool PERM = false;
    const float* X; float* H1; bf16_t* H1B; float* SSQ;
    __device__ __forceinline__ void operator()(const f32x4 (&acc)[2][2][4][2], const Unit& u, int wr, int wc, int fr, int fq) const {
        const int row0 = u.pm * BM + wr * 64 + fr, col0 = u.pn * BM + wc * 32 + 4 * fq;
#pragma unroll
        for (int ai = 0; ai < 2; ++ai)
#pragma unroll
            for (int m = 0; m < 4; ++m) { const int row = row0 + ai * HALF + m * 16; const size_t ro = (size_t)row * DM + col0; float ss = 0.f;
#pragma unroll
                for (int bj = 0; bj < 2; ++bj)
#pragma unroll
                    for (int n = 0; n < 2; ++n) { const size_t o = ro + bj * HALF + n * 16;
                        const f32x4 h = *(const f32x4*)(X + o) + acc[ai][bj][m][n];
                        *(f32x4*)(H1 + o) = h; u32x2 w; w.x = cvt_pk_bf16(h[0], h[1]); w.y = cvt_pk_bf16(h[2], h[3]); *(u32x2*)(H1B + o) = w;
                        ss += (h[0] * h[0] + h[1] * h[1]) + (h[2] * h[2] + h[3] * h[3]); }
                ss += __shfl_xor(ss, 16); ss += __shfl_xor(ss, 32);
                if (fq == 0) atomicAdd(SSQ + row, ss); }
    }
};
struct EpiSwiglu {
    static constexpr bool PERM = true;
    const float* SSQ; bf16_t* HFF;
    __device__ __forceinline__ void operator()(const f32x4 (&acc)[2][2][4][2], const Unit& u, int wr, int wc, int fr, int fq) const {
        const int row0 = u.pm * BM + wr * 64 + fr, col0 = u.pn * HALF + wc * 32 + 8 * fq;
#pragma unroll
        for (int ai = 0; ai < 2; ++ai)
#pragma unroll
            for (int m = 0; m < 4; ++m) { const int row = row0 + ai * HALF + m * 16;
                const float rstd = 1.0f / sqrtf(SSQ[row] * (1.0f / DM) + EPS);
                f32x4 o[2];
#pragma unroll
                for (int n = 0; n < 2; ++n)
#pragma unroll
                    for (int e = 0; e < 4; ++e) { const float gg = acc[ai][0][m][n][e] * rstd, uu = acc[ai][1][m][n][e] * rstd; o[n][e] = gg * sigmoidf_(gg) * uu; }
                *(u32x4*)(HFF + (size_t)row * DFF + col0) = pack8u(o[0], o[1]); }
    }
};
struct EpiDown {
    static constexpr bool PERM = false;
    float* OUT; float* SSQ;
    __device__ __forceinline__ void operator()(const f32x4 (&acc)[2][2][4][2], const Unit& u, int wr, int wc, int fr, int fq) const {
        const int row0 = u.pm * BM + wr * 64 + fr, col0 = u.pn * BM + wc * 32 + 4 * fq;
#pragma unroll
        for (int ai = 0; ai < 2; ++ai)
#pragma unroll
            for (int m = 0; m < 4; ++m) { const int row = row0 + ai * HALF + m * 16; const size_t ro = (size_t)row * DM + col0; float ss = 0.f;
#pragma unroll
                for (int bj = 0; bj < 2; ++bj)
#pragma unroll
                    for (int n = 0; n < 2; ++n) { const size_t o = ro + bj * HALF + n * 16;
                        const f32x4 h = *(const f32x4*)(OUT + o) + acc[ai][bj][m][n];
                        *(f32x4*)(OUT + o) = h;
                        ss += (h[0] * h[0] + h[1] * h[1]) + (h[2] * h[2] + h[3] * h[3]); }
                ss += __shfl_xor(ss, 16); ss += __shfl_xor(ss, 32);
                if (fq == 0) atomicAdd(SSQ + row, ss); }
    }
};
}

namespace att {
constexpr int NW = 8, QBLK = 32, KVBLK = 64, QB = NW * QBLK, D = 128, RS = DM;
constexpr int SHM_V = KVBLK * D * 2, SHM_K = KVBLK * D * 2;
constexpr int LDS_BYTES = 2 * SHM_V + 2 * SHM_K + NW * 128 * 4;
constexpr int LDS_STAGE = LDS_BYTES;
constexpr unsigned PO_STRIDE = 32u << 20, LSE_STRIDE = (unsigned)(MTOK * NHEAD * 4);
__device__ __forceinline__ unsigned po_of(unsigned po0, unsigned po2, unsigned j) { const unsigned p = po0 + j * PO_STRIDE; return j == 2u ? po2 : p; }
constexpr float THR = 8.f;
#define KSWZ(row, colB) ((row) * 256 + ((colB) ^ (((row) & 7) << 4)))
#define SBAR() __builtin_amdgcn_sched_barrier(0)
__device__ __forceinline__ int v_st(int k, int c) { const int kk = (k & ~0xC) | ((k & 4) << 1) | ((k & 8) >> 1); return ((kk >> 3) * 4 + (c >> 5)) * 512 + ((kk & 7) * 32 + (c & 31)) * 2; }
__device__ __forceinline__ int v_rd_base(int lane) { return ((lane & 3) << 3) | (((lane >> 2) & 3) << 6) | (((lane >> 4) & 1) << 5) | (((lane >> 5) & 1) << 8); }
constexpr int v_rd_off(int d0, int ks, int half) { return d0 * 512 + ks * 4096 + half * 2048; }
__device__ __forceinline__ int crow(int r, int hi) { return (r & 3) + 8 * (r >> 2) + 4 * hi; }
__device__ __forceinline__ unsigned cvtpk(float lo, float hi) { unsigned r; asm volatile("v_cvt_pk_bf16_f32 %0, %1, %2" : "=v"(r) : "v"(lo), "v"(hi)); return r; }
__device__ __forceinline__ bf16x8 load8(const bf16_t* p) { return *reinterpret_cast<const bf16x8*>(p); }
__device__ __forceinline__ void mask_causal(f32x16& p0, f32x16& p1, int dq) {
    const float NEG = -__builtin_inff();
#pragma unroll
    for (int r = 0; r < 16; ++r) { const int c = (r & 3) + 8 * (r >> 2);
        if (dq - c < 0) p0[r] = NEG;
        if (dq - c - 32 < 0) p1[r] = NEG; }
}
__device__ __forceinline__ void mask_row(f32x16& p0, f32x16& p1, bool keep) {
    const float NEG = -__builtin_inff();
#pragma unroll
    for (int r = 0; r < 16; ++r) { p0[r] = keep ? p0[r] : NEG; p1[r] = keep ? p1[r] : NEG; }
}
__device__ __forceinline__ void partialSM(f32x16& p0, f32x16& p1, float& m_reg, float& mn, float& alpha) {
    float pmax = p0[0];
#pragma unroll
    for (int r = 1; r < 16; ++r) pmax = fmaxf(pmax, p0[r]);
#pragma unroll
    for (int r = 0; r < 16; ++r) pmax = fmaxf(pmax, p1[r]);
    { auto rr = __builtin_amdgcn_permlane32_swap(__float_as_uint(pmax), __float_as_uint(pmax), false, false);
      pmax = fmaxf(__uint_as_float(rr[0]), __uint_as_float(rr[1])); }
    if (__builtin_expect(__all((pmax - m_reg) <= THR), 1)) { mn = m_reg; alpha = 1.f; }
    else { mn = fmaxf(m_reg, pmax); alpha = __builtin_amdgcn_exp2f(m_reg - mn); m_reg = mn; }
#pragma unroll
    for (int r = 0; r < 16; ++r) p0[r] = p0[r] - mn;
#pragma unroll
    for (int r = 0; r < 16; ++r) p1[r] = p1[r] - mn;
#pragma unroll
    for (int r = 0; r < 16; ++r) p0[r] = __builtin_amdgcn_exp2f(p0[r]);
}
__device__ __forceinline__ void finishSM(f32x16& p0, f32x16& p1, float alpha, float& l_reg, bf16x8& pa0, bf16x8& pa1, bf16x8& pa2, bf16x8& pa3) {
#pragma unroll
    for (int r = 0; r < 16; ++r) p1[r] = __builtin_amdgcn_exp2f(p1[r]);
    float ps = 0;
#pragma unroll
    for (int r = 0; r < 16; ++r) ps += p0[r];
#pragma unroll
    for (int r = 0; r < 16; ++r) ps += p1[r];
    { auto rr = __builtin_amdgcn_permlane32_swap(__float_as_uint(ps), __float_as_uint(ps), false, false);
      ps = __uint_as_float(rr[0]) + __uint_as_float(rr[1]); }
    l_reg = l_reg * alpha + ps;
#define PK4(P, B_, OUT) do { unsigned a0 = cvtpk(P[B_+0], P[B_+1]), a1 = cvtpk(P[B_+2], P[B_+3]);                          \
        unsigned b0 = cvtpk(P[B_+4], P[B_+5]), b1 = cvtpk(P[B_+6], P[B_+7]);                                             \
        auto r0 = __builtin_amdgcn_permlane32_swap(a0, b0, false, false); auto r1 = __builtin_amdgcn_permlane32_swap(a1, b1, false, false); \
        u32x4 w = {r0[0], r1[0], r0[1], r1[1]}; OUT = *reinterpret_cast<bf16x8*>(&w); } while (0)
    PK4(p0, 0, pa0); PK4(p0, 8, pa1); PK4(p1, 0, pa2); PK4(p1, 8, pa3);
#undef PK4
}
template <int KB>
__device__ __forceinline__ void qkt(f32x16& p0, f32x16& p1, const char* K_lds, int r32, int hi, const bf16x8* qr, bool act) {
    if (!act) { const float NEG = -__builtin_inff();
#pragma unroll
        for (int r = 0; r < 16; ++r) { p0[r] = NEG; p1[r] = NEG; } return; }
    p0 = f32x16{}; p1 = f32x16{};
    const char* kb[4];
#pragma unroll
    for (int dd = 0; dd < 4; ++dd) kb[dd] = K_lds + KB * SHM_K + KSWZ(r32, (dd * 16 + hi * 8) * 2);
#pragma unroll
    for (int d0 = 0; d0 < 8; ++d0) { const char* a = kb[d0 & 3] + (d0 >> 2) * 128;
        bf16x8 b0 = *reinterpret_cast<const bf16x8*>(a);
        bf16x8 b1 = *reinterpret_cast<const bf16x8*>(a + 32 * 256);
        p0 = __builtin_amdgcn_mfma_f32_32x32x16_bf16(b0, qr[d0], p0, 0, 0, 0);
        p1 = __builtin_amdgcn_mfma_f32_32x32x16_bf16(b1, qr[d0], p1, 0, 0, 0); }
}
template <int VB>
__device__ __forceinline__ void pv_tile(f32x16* o, int vb0, bf16x8 pa0, bf16x8 pa1, bf16x8 pa2, bf16x8 pa3, bool act) {
    if (!act) return;
#define TRRD(dst, off) asm volatile("ds_read_b64_tr_b16 %0, %1 offset:%2" : "=&v"(dst) : "v"(vb0), "i"(off) : "memory")
#define PV_D0(d0) do { s16x4 l0, l1, l2, l3, h0, h1, h2, h3; constexpr int b_ = VB * SHM_V + v_rd_off(d0, 0, 0); \
        TRRD(l0, b_); TRRD(h0, b_ + 2048); TRRD(l1, b_ + 4096); TRRD(h1, b_ + 6144); TRRD(l2, b_ + 8192); TRRD(h2, b_ + 10240); TRRD(l3, b_ + 12288); TRRD(h3, b_ + 14336); \
        asm volatile("s_waitcnt lgkmcnt(0)" ::: "memory"); SBAR();   \
        o[d0] = __builtin_amdgcn_mfma_f32_32x32x16_bf16(pa0, (bf16x8){l0[0], l0[1], l0[2], l0[3], h0[0], h0[1], h0[2], h0[3]}, o[d0], 0, 0, 0);   \
        o[d0] = __builtin_amdgcn_mfma_f32_32x32x16_bf16(pa1, (bf16x8){l1[0], l1[1], l1[2], l1[3], h1[0], h1[1], h1[2], h1[3]}, o[d0], 0, 0, 0);   \
        o[d0] = __builtin_amdgcn_mfma_f32_32x32x16_bf16(pa2, (bf16x8){l2[0], l2[1], l2[2], l2[3], h2[0], h2[1], h2[2], h2[3]}, o[d0], 0, 0, 0);   \
        o[d0] = __builtin_amdgcn_mfma_f32_32x32x16_bf16(pa3, (bf16x8){l3[0], l3[1], l3[2], l3[3], h3[0], h3[1], h3[2], h3[3]}, o[d0], 0, 0, 0); } while (0)
    PV_D0(0); PV_D0(1); PV_D0(2); PV_D0(3);
#undef PV_D0
#undef TRRD
}
struct BlockRef { const bf16_t* Qb; const bf16_t* K; const bf16_t* V; const unsigned short* list; int nrows; int qb; unsigned po0, po2, lo0; bf16_t* O; };
struct Seam { bf16x8 qr[8]; bf16x8 st_v0, st_v1, st_k0, st_k1; int ent; };
#define LD16(base, off) (*reinterpret_cast<const bf16x8*>((const char*)(base) + (off)))
#define VMW() asm volatile("s_waitcnt vmcnt(0)" ::: "memory")
#define VMWN(n) asm volatile("s_waitcnt vmcnt(%0)" :: "i"(n) : "memory")
#define SLOAD_H(Kp, Vp, k0) do { const char* kb_ = (const char*)(Kp) + (size_t)(k0) * (RS * 2); const char* vb_ = (const char*)(Vp) + (size_t)(k0) * (RS * 2); \
                         S.st_v0 = LD16(vb_, lofs); S.st_v1 = LD16(vb_ + 32 * RS * 2, lofs);              \
                         S.st_k0 = LD16(kb_, lofs); S.st_k1 = LD16(kb_ + 32 * RS * 2, lofs); } while (0)
#define SWRITE_HK(bf) do { *(bf16x8*)(K_lds + (bf) * SHM_K + kws) = S.st_k0; *(bf16x8*)(K_lds + (bf) * SHM_K + kws + 32 * 256) = S.st_k1; } while (0)
#define SWRITE_HV(bf) do { *(bf16x8*)(V_lds + (bf) * SHM_V + vst0) = S.st_v0; *(bf16x8*)(V_lds + (bf) * SHM_V + vst1) = S.st_v1; } while (0)
#define SWRITE_H(bf) do { SWRITE_HV(bf); SWRITE_HK(bf); } while (0)
__host__ __device__ __forceinline__ int list_off(int n) { return 256 * (31 * n - (n * (n - 1)) / 2); }

__device__ __forceinline__ void gate_lists(const bf16_t* Qb, const float* KM, int qb, unsigned* CNT, unsigned short* LISTbh) {
    int tid = threadIdx.x; asm volatile("" : "+v"(tid));
    const int wid = __builtin_amdgcn_readfirstlane(tid >> 6), lane = tid & 63, r32 = lane & 31, hi = lane >> 5;
    if (qb == 0) return;
    const int srow = qb * QB + wid * QBLK + r32;
    bf16x8 qr[8];
    { const unsigned qofs = (unsigned)(srow * RS + hi * 8) * 2u;
#pragma unroll
      for (int d0 = 0; d0 < 8; ++d0) qr[d0] = LD16((const char*)Qb + d0 * 32, qofs); }
    unsigned sel = 0u;
    {
        f32x16 g = f32x16{};
#pragma unroll
        for (int d0 = 0; d0 < 8; ++d0) {
            const char* kp = (const char*)KM + d0 * 64; const unsigned kofs = (unsigned)(r32 * D + hi * 8) * 4u;
            const f32x4 a = *(const f32x4*)(kp + kofs), b = *(const f32x4*)(kp + 16 + kofs);
            const u32x4 wh = pack8u(a, b); f32x4 ah, bh; unpack8(wh, ah, bh);
            const u32x4 wl = pack8u(a - ah, b - bh);
            g = __builtin_amdgcn_mfma_f32_32x32x16_bf16(*reinterpret_cast<const bf16x8*>(&wh), qr[d0], g, 0, 0, 0);
            g = __builtin_amdgcn_mfma_f32_32x32x16_bf16(*reinterpret_cast<const bf16x8*>(&wl), qr[d0], g, 0, 0, 0);
        }
        const float NEG = -__builtin_inff();
#pragma unroll
        for (int r = 0; r < 16; ++r) if (crow(r, hi) >= qb) g[r] = NEG;
#pragma unroll
        for (int round = 0; round < 3; ++round) {
            float bv = NEG; int bn = 64;
#pragma unroll
            for (int r = 0; r < 16; ++r) if (g[r] > bv) { bv = g[r]; bn = crow(r, hi); }
            const float ov = __shfl_xor(bv, 32); const int on = __shfl_xor(bn, 32);
            if (ov > bv || (ov == bv && on < bn)) { bv = ov; bn = on; }
            if (bv > NEG) sel |= 1u << bn;
#pragma unroll
            for (int r = 0; r < 16; ++r) if (crow(r, hi) == bn) g[r] = NEG;
        }
    }
    const bool lo = hi == 0;
    unsigned mycnt = 0u;
    for (int n = 0; n < qb; ++n) { const unsigned long long m = __ballot(lo && ((sel >> n) & 1u)); if (lane == n) mycnt = (unsigned)__popcll(m); }
    unsigned mybase = 0u;
    if (lane < qb && mycnt) mybase = atomicAdd(CNT + lane, mycnt);
    for (int n = 0; n < qb; ++n) {
        const bool bit = lo && ((sel >> n) & 1u); const unsigned long long m = __ballot(bit);
        const unsigned base = __shfl(mybase, n);
        if (bit) { const unsigned rank = (unsigned)__popcll(m & ((1ull << lane) - 1ull)), j = (unsigned)__popc(sel & ((1u << n) - 1u));
            LISTbh[list_off(n) + base + rank] = (unsigned short)((unsigned)srow | (j << 13)); }
    }
}

template <int MODE>
__device__ __forceinline__ void attn_prime(const BlockRef& cur, char* lds, Seam& S) {
    int tid = threadIdx.x; asm volatile("" : "+v"(tid));
    const int wid = __builtin_amdgcn_readfirstlane(tid >> 6), lane = tid & 63, r32 = lane & 31, hi = lane >> 5;
    const int sr = tid >> 4, sc = (tid & 15) * 8, kws = KSWZ(sr, sc * 2); char* K_lds = lds + 2 * SHM_V;
    const unsigned lofs = (unsigned)(sr * RS + sc) * 2u;
    int srow;
    if (MODE == 0) { int idx = wid * QBLK + r32; idx = idx < cur.nrows ? idx : cur.nrows - 1; S.ent = cur.list[idx]; srow = S.ent & 0x1fff; }
    else { S.ent = 0; srow = cur.qb * QB + wid * QBLK + r32; }
    { const unsigned qofs = (unsigned)(srow * RS + hi * 8) * 2u;
#pragma unroll
      for (int d0 = 0; d0 < 8; ++d0) S.qr[d0] = LD16((const char*)cur.Qb + d0 * 32, qofs); }
    SLOAD_H(cur.K, cur.V, 0); VMW(); SWRITE_HK(0);
    __syncthreads();
}
template <int MODE>
__device__ __forceinline__ void attn_block(const BlockRef& cur, const BlockRef& nxt, char* lds, Seam& S, unsigned char* wsb) {
    int tid = threadIdx.x; asm volatile("" : "+v"(tid));
    const int wid = __builtin_amdgcn_readfirstlane(tid >> 6), lane = tid & 63, r32 = lane & 31, hi = lane >> 5;
    constexpr int NT = 4;
    const int qrel = wid * QBLK;
    const bool wact = MODE == 0 ? (qrel < cur.nrows) : true;
    char* V_lds = lds; char* K_lds = lds + 2 * SHM_V;
    float* ws = (float*)(lds + 2 * SHM_V + 2 * SHM_K) + wid * 128; float* li_l = ws, * al_l = ws + 32, * t2_l = ws + 64, * t3_l = ws + 96;
    int ent_nx = 0;
    if (MODE == 0) { int idx = qrel + r32; idx = idx < nxt.nrows ? idx : nxt.nrows - 1; ent_nx = nxt.list[idx]; }
    float m_reg = -1e30f, l_reg = 0; f32x16 o[4] = {};
    const int sr = tid >> 4, sc = (tid & 15) * 8, vst0 = v_st(sr, sc), vst1 = v_st(32 + sr, sc), kws = KSWZ(sr, sc * 2);
    const unsigned lofs = (unsigned)(sr * RS + sc) * 2u;
    const int vb0 = (int)(uintptr_t)V_lds + v_rd_base(lane);
    const bf16_t* Kh = cur.K; const bf16_t* Vh = cur.V;
#define RESC(a) do { if (__any((a) < 1.f)) { if (hi == 0) al_l[r32] = (a); asm volatile("s_waitcnt lgkmcnt(0)" ::: "memory");              \
                     for (int d_ = 0; d_ < 4; ++d_) for (int r = 0; r < 16; ++r) o[d_][r] *= al_l[crow(r, hi)]; } } while (0)
#define KBASE(t) ((t) * KVBLK)
#define ACT(t) (MODE == 0 ? wact : (((t) * KVBLK) <= qrel + QBLK - 1))
#define MASKT(P0_, P1_, t) do { if (MODE == 1) { const int kbl_ = (t) * KVBLK; if (kbl_ + KVBLK - 1 > qrel) mask_causal(P0_, P1_, qrel + r32 - 4 * hi - kbl_); } } while (0)
    constexpr int NQL = 8;
#define SEAM_K0() do { VMWN(NQL); SWRITE_HK(0); SBAR(); } while (0)
    f32x16 pA0, pA1, pB0, pB1; float mnA, mnB, alA, alB; bf16x8 pa0, pa1, pa2, pa3;
    SWRITE_HV(0); SBAR();
    SLOAD_H(Kh, Vh, KBASE(1));
    SBAR(); qkt<0>(pA0, pA1, K_lds, r32, hi, S.qr, ACT(0));
    MASKT(pA0, pA1, 0); partialSM(pA0, pA1, m_reg, mnA, alA);
    VMW(); SWRITE_H(1);
    __syncthreads();
#define HALF_STEP(PX0, PX1, mnX, alX, PY0, PY1, alY, t, KB, VB, SB) do {                                                      \
        SBAR(); qkt<KB>(PX0, PX1, K_lds, r32, hi, S.qr, ACT(t));                                             \
        finishSM(PY0, PY1, alY, l_reg, pa0, pa1, pa2, pa3); SBAR();                                                           \
        if ((t) + 1 < NT) { SLOAD_H(Kh, Vh, KBASE((t) + 1)); SBAR(); }                                               \
        pv_tile<VB>(o, vb0, pa0, pa1, pa2, pa3, ACT((t) - 1)); MASKT(PX0, PX1, (t)); partialSM(PX0, PX1, m_reg, mnX, alX);                                        \
        __syncthreads();                                                                                                      \
        if ((t) + 1 < NT) { VMW(); SWRITE_H(SB); }                                                                          \
        RESC(alX); __syncthreads(); } while (0)
    HALF_STEP(pB0, pB1, mnB, alB, pA0, pA1, alA, 1, 1, 0, 0);
    HALF_STEP(pA0, pA1, mnA, alA, pB0, pB1, alB, 2, 0, 1, 1);
    SBAR(); qkt<1>(pB0, pB1, K_lds, r32, hi, S.qr, ACT(NT - 1)); SBAR();
    SLOAD_H(nxt.K, nxt.V, 0); SBAR();
    { const int srown = MODE == 0 ? (ent_nx & 0x1fff) : (nxt.qb * QB + wid * QBLK + r32); const unsigned qofs = (unsigned)(srown * RS + hi * 8) * 2u;
#pragma unroll
    for (int d0 = 0; d0 < 8; ++d0) S.qr[d0] = LD16((const char*)nxt.Qb + d0 * 32, qofs); }
    SBAR();
    finishSM(pA0, pA1, alA, l_reg, pa0, pa1, pa2, pa3); SBAR();
    pv_tile<0>(o, vb0, pa0, pa1, pa2, pa3, ACT(NT - 2));
    MASKT(pB0, pB1, NT - 1); partialSM(pB0, pB1, m_reg, mnB, alB); __syncthreads(); RESC(alB);
    finishSM(pB0, pB1, alB, l_reg, pa0, pa1, pa2, pa3); SBAR(); pv_tile<1>(o, vb0, pa0, pa1, pa2, pa3, ACT(NT - 1));
    SBAR(); SEAM_K0();
    if (MODE == 0) {
        const int ent = S.ent;
        if (hi == 0) { li_l[r32] = l_reg; ((int*)al_l)[r32] = ent; } asm volatile("s_waitcnt lgkmcnt(0)" ::: "memory");
        if (hi == 0 && qrel + r32 < cur.nrows) { const unsigned j = (unsigned)ent >> 13; const unsigned lofsj = cur.lo0 + j * LSE_STRIDE + (unsigned)(ent & 0x1fff) * 4u;
            *(float*)(wsb + lofsj) = m_reg + __builtin_amdgcn_logf(l_reg); }
#pragma unroll
        for (int r = 0; r < 16; ++r) { const int rw = crow(r, hi); const float rl = __builtin_amdgcn_rcpf(li_l[rw]); const int e = ((const int*)al_l)[rw];
            const bool valid = qrel + rw < cur.nrows; const unsigned j = (unsigned)e >> 13;
            const unsigned ob = po_of(cur.po0, cur.po2, j) + (unsigned)((e & 0x1fff) * RS + r32) * 2u;
#pragma unroll
            for (int d0 = 0; d0 < 4; ++d0) { const float v = o[d0][r] * rl; const float vn = __shfl_xor(v, 1);
                if ((r32 & 1) == 0 && valid) *(unsigned*)(wsb + ob + d0 * 64) = cvtpk(v, vn); } }
    } else {
        const int nprev = cur.qb < 3 ? cur.qb : 3;
        const int srow = cur.qb * QB + qrel + r32;
        {   const float NEG = -__builtin_inff();
            float l0 = NEG, l1 = NEG, l2 = NEG;
            if (nprev > 0) l0 = *(const float*)(wsb + cur.lo0 + (unsigned)srow * 4u);
            if (nprev > 1) l1 = *(const float*)(wsb + cur.lo0 + LSE_STRIDE + (unsigned)srow * 4u);
            if (nprev > 2) l2 = *(const float*)(wsb + cur.lo0 + 2u * LSE_STRIDE + (unsigned)srow * 4u);
            const float M = fmaxf(fmaxf(m_reg, l0), fmaxf(l1, l2));
            const float wo = __builtin_amdgcn_exp2f(m_reg - M), w0 = __builtin_amdgcn_exp2f(l0 - M), w1 = __builtin_amdgcn_exp2f(l1 - M), w2 = __builtin_amdgcn_exp2f(l2 - M);
            const float rL = 1.0f / (l_reg * wo + w0 + w1 + w2);
            if (hi == 0) { li_l[r32] = wo * rL; al_l[r32] = w0 * rL; t2_l[r32] = w1 * rL; t3_l[r32] = w2 * rL; }
            asm volatile("s_waitcnt lgkmcnt(0)" ::: "memory");
        }
#pragma unroll
        for (int r = 0; r < 16; ++r) { const float w = li_l[crow(r, hi)];
#pragma unroll
            for (int d0 = 0; d0 < 4; ++d0) o[d0][r] *= w; }
        char* stg = lds + LDS_STAGE + wid * (32 * 272);
        for (int j = 0; j < nprev; ++j) {
            const unsigned pb = po_of(cur.po0, cur.po2, (unsigned)j) + (unsigned)((cur.qb * QB + qrel) * RS) * 2u;
            const float* wt = j == 0 ? al_l : j == 1 ? t2_l : t3_l;
#pragma unroll
            for (int i = 0; i < 8; ++i) { const int ch = i * 64 + lane, row = ch >> 4, c16 = ch & 15;
                const u32x4 v = *(const u32x4*)(wsb + pb + (unsigned)(row * RS + c16 * 8) * 2u); *(u32x4*)(stg + row * 272 + c16 * 16) = v; }
            asm volatile("s_waitcnt lgkmcnt(0)" ::: "memory");
#pragma unroll
            for (int r = 0; r < 16; ++r) { const int rw = crow(r, hi); const float w = wt[rw];
#pragma unroll
                for (int d0 = 0; d0 < 4; ++d0) { const unsigned short hv = *(const unsigned short*)(stg + rw * 272 + (d0 * 32 + r32) * 2);
                    o[d0][r] += w * __uint_as_float((unsigned)hv << 16); } }
            asm volatile("s_waitcnt lgkmcnt(0)" ::: "memory");
        }
        char* Ow = (char*)cur.O + (size_t)(cur.qb * QB + qrel) * (RS * 2);
        const unsigned oofs = (unsigned)((4 * hi) * RS + r32) * 2u;
#pragma unroll
        for (int r = 0; r < 16; ++r) { const int orow = (r & 3) + 8 * (r >> 2);
#pragma unroll
            for (int d0 = 0; d0 < 4; ++d0) { const float v = o[d0][r]; const float vn = __shfl_xor(v, 1);
                if ((r32 & 1) == 0) *(unsigned*)(Ow + (orow * RS + d0 * 32) * 2 + oofs) = cvtpk(v, vn); } }
    }
    S.ent = ent_nx;
    __syncthreads();
#undef RESC
#undef KBASE
#undef ACT
#undef MASKT
#undef SEAM_K0
#undef HALF_STEP
}
#undef LD16
#undef VMW
#undef VMWN
#undef SLOAD_H
#undef SWRITE_HK
#undef SWRITE_HV
#undef SWRITE_H
#undef KSWZ
#undef SBAR
}

constexpr size_t MiB = 1u << 20;
constexpr size_t WS_CTL = 0, CTL_ZERO_BYTES = 1 * MiB;
constexpr size_t WS_BAR = 16384;
constexpr size_t WS_CNT = 128 * 1024;
constexpr size_t WS_SSQ1 = 256 * 1024, WS_SSQ2 = 320 * 1024, WS_KM = 512 * 1024;
constexpr size_t WS_WIN = 1 * MiB;
constexpr size_t WS_WAC = 17 * MiB;
constexpr size_t WS_WOUT = 21 * MiB;
constexpr size_t WS_WGU = 23 * MiB;
constexpr size_t WS_WDN = 34 * MiB;
constexpr size_t WS_ROPE = 40 * MiB;
constexpr size_t WS_U = 42 * MiB;
constexpr size_t WS_V = 74 * MiB, WS_P = 106 * MiB, WS_BG = 138 * MiB, WS_SGA = 170 * MiB, WS_SGC = 202 * MiB;
constexpr size_t WS_T = 74 * MiB;
constexpr size_t WS_MG = 138 * MiB;
constexpr size_t WS_H1B = 170 * MiB;
constexpr size_t WS_HFF = 42 * MiB;
constexpr size_t WS_PO0 = 106 * MiB, WS_PO1 = 138 * MiB;
constexpr size_t WS_PO2A = 1 * MiB;
constexpr size_t WS_PO2B = 234 * MiB;
constexpr size_t WS_LSE = 250 * MiB;
constexpr size_t WS_LIST = 252 * MiB;
constexpr int LIST_PER_BH = 256 * 496;
constexpr size_t WS_END = 256 * MiB;
constexpr int LDS_BYTES = 147456;
constexpr int NTHREADS = 512;
constexpr int LDS_MISC = LDS_BYTES - 256;


#define XB_TMO      128
#define XB_XCNT(j)  (256  + 64 * (j))
#define XB_XSUB(j)  (1280 + 64 * (j))
#define XB_XGEN(j)  (2304 + 64 * (j))
#define XB_TOP      3328
#define XB_TOPGEN   3392
#define XCD_BAR_WORDS 3456
#define XB_SPIN_CAP (1u << 18)
__device__ __forceinline__ unsigned xb_ld(unsigned* p)              { return __hip_atomic_load(p, __ATOMIC_RELAXED, __HIP_MEMORY_SCOPE_AGENT); }
__device__ __forceinline__ unsigned xb_add(unsigned* p, unsigned v) { return __hip_atomic_fetch_add(p, v, __ATOMIC_RELAXED, __HIP_MEMORY_SCOPE_AGENT); }
__device__ __forceinline__ unsigned xb_xcc_id() { return (unsigned)__builtin_amdgcn_s_getreg((3 << 11) | 20) & 0xFu; }
#define XB_SPIN(cond, bar) do { unsigned _sp = 0; while (cond) { __builtin_amdgcn_s_sleep(1); \
    if ((++_sp & 255u) == 0u) { if (xb_ld(&(bar)[XB_TMO])) break; if (_sp > XB_SPIN_CAP) { atomicAdd(&(bar)[XB_TMO], 1u); break; } } } } while (0)
struct XcdBarrier { unsigned* bar; unsigned x; volatile LAS unsigned* st; };
__device__ __forceinline__ XcdBarrier xcd_barrier_post(unsigned* bar, volatile LAS unsigned* st) {
    XcdBarrier b; b.bar = bar; b.x = xb_xcc_id(); b.st = st;
    if (threadIdx.x == 0) (void)xb_add(&bar[XB_XCNT(b.x)], 1u);
    return b;
}
__device__ __forceinline__ void xcd_barrier_complete(unsigned* bar, unsigned x, unsigned& nloc, unsigned& nx) {
    const unsigned G = gridDim.x * gridDim.y * gridDim.z;
    unsigned sum, cnt, mine, sp = 0u;
    for (;;) {
        sum = 0u; cnt = 0u; mine = 0u;
#pragma unroll
        for (unsigned j = 0; j < 16; ++j) { const unsigned c = xb_ld(&bar[XB_XCNT(j)]); sum += c; cnt += (c > 0u) ? 1u : 0u; mine = (j == x) ? c : mine; }
        if (sum == G) break;
        __builtin_amdgcn_s_sleep(1);
        if ((++sp & 255u) == 0u) { if (xb_ld(&bar[XB_TMO])) break; if (sp > XB_SPIN_CAP) { atomicAdd(&bar[XB_TMO], 1u); break; } }
    }
    nloc = mine > 0u ? mine : 1u; nx = cnt > 0u ? cnt : 1u;
}
__device__ __forceinline__ void xcd_barrier(const XcdBarrier& b) {
    asm volatile("s_waitcnt vmcnt(0)" ::: "memory");
    __syncthreads();
    if (threadIdx.x == 0) {
        unsigned* bar = b.bar;
        __builtin_amdgcn_s_waitcnt(0);
        unsigned nloc = b.st[0], nx = b.st[1];
        if (nloc == 0u) { xcd_barrier_complete(bar, b.x, nloc, nx); b.st[0] = nloc; b.st[1] = nx; }
        const unsigned old = xb_add(&bar[XB_XSUB(b.x)], 1u);
        const unsigned gen = old / nloc;
        if (old + 1u == (gen + 1u) * nloc) {
            __builtin_amdgcn_fence(__ATOMIC_RELEASE, "agent");
            asm volatile("s_waitcnt vmcnt(0)" ::: "memory");
            const unsigned og = xb_add(&bar[XB_TOP], 1u);
            const unsigned tg = og / nx;
            if (og + 1u == (tg + 1u) * nx) xb_add(&bar[XB_TOPGEN], 1u);
            else XB_SPIN(xb_ld(&bar[XB_TOPGEN]) == tg, bar);
            __builtin_amdgcn_fence(__ATOMIC_ACQUIRE, "agent");
            xb_add(&bar[XB_XGEN(b.x)], 1u);
            asm volatile("s_waitcnt vmcnt(0)" ::: "memory");
        } else {
            XB_SPIN(xb_ld(&bar[XB_XGEN(b.x)]) == gen, bar);
            __builtin_amdgcn_fence(__ATOMIC_ACQUIRE, "agent");
            asm volatile("s_waitcnt vmcnt(0)" ::: "memory");
        }
    }
    __syncthreads();
}

struct Args { const float* in[11]; float* out; unsigned char* ws; int use_cg; int pad; };

__device__ __forceinline__ size_t opq0() { size_t z = 0; asm volatile("" : "+s"(z)); return z; }
__device__ __forceinline__ float wave_sum(float v) {
#pragma unroll
    for (int o = 1; o < 64; o <<= 1) v += __shfl_xor(v, o);
    return v;
}
__device__ __forceinline__ void transpose_item(const float* W, int N, bf16_t* WT, int Kld, int k0, int n0, int dst_row0, const float* kscale, LAS float* scr, int lane) {
#pragma unroll 8
    for (int i = 0; i < 32; ++i) { const int kk = 2 * i + (lane >> 5); float v = W[(size_t)(k0 + kk) * N + n0 + (lane & 31)]; if (kscale) v *= kscale[k0 + kk]; scr[kk * 33 + (lane & 31)] = v; }
    asm volatile("s_waitcnt lgkmcnt(0)" ::: "memory");
    const int c = lane & 7;
#pragma unroll
    for (int j = 0; j < 4; ++j) { const int n = (lane >> 3) + 8 * j; const LAS float* s = scr + (8 * c) * 33 + n;
        u32x4 o; o.x = cvt_pk_bf16(s[0 * 33], s[1 * 33]); o.y = cvt_pk_bf16(s[2 * 33], s[3 * 33]); o.z = cvt_pk_bf16(s[4 * 33], s[5 * 33]); o.w = cvt_pk_bf16(s[6 * 33], s[7 * 33]);
        *(u32x4*)(WT + (size_t)(dst_row0 + n) * Kld + k0 + 8 * c) = o; }
    asm volatile("s_waitcnt lgkmcnt(0)" ::: "memory");
}
__device__ __forceinline__ int map_in(int n0) {
    if (n0 < 3072) return n0;
    if (n0 < 4096) { const int j = n0 - 3072; return 256 * (12 + (j >> 7)) + (j & 127); }
    if (n0 < 5120) return 5120 + (n0 - 4096);
    if (n0 < 6144) { const int j = n0 - 5120; return 256 * (12 + (j >> 7)) + 128 + (j & 127); }
    return n0;
}
__device__ __forceinline__ int map_gu(int n0) { const int j = n0 < DFF ? n0 : n0 - DFF; return 256 * (j >> 7) + (n0 < DFF ? 0 : 128) + (j & 127); }


#ifndef DBG_ATTN
#define DBG_ATTN 0
#endif
#if DBG_ATTN
__device__ __forceinline__ void dbg_check(const bf16_t* QC, const bf16_t* Kg, const bf16_t* Vg, const bf16_t* ATTN, const float* KM, unsigned* dbgmax, LAS unsigned char* lds, int gw, int NGW, int lane, int wave) {
    LAS float* qs = (LAS float*)(lds + wave * 8192);
    LAS float* sc = qs + 128;
    const float NEG = -__builtin_inff();
    for (int task = gw; task * 5 < MTOK * NHEAD; task += NGW) {
        const int flat = task * 5, b = flat >> 16, s = (flat >> 3) & (SEQ - 1), h = flat & 7, blk = s >> 8;
        const size_t rowoff = ((size_t)b * SEQ + s) * DM + h * HD;
        { const unsigned w = *(const unsigned*)(QC + rowoff + 2 * lane); qs[2 * lane] = bf_lo(w); qs[2 * lane + 1] = bf_hi(w); }
        asm volatile("s_waitcnt lgkmcnt(0)" ::: "memory");
        float g = NEG;
        if (lane < blk) { const float* km = KM + ((size_t)(b * NHEAD + h) * NKB + lane) * HD; float a = 0.f; for (int d = 0; d < HD; ++d) a += qs[d] * km[d]; g = a; }
        int sb0 = -1, sb1 = -1, sb2 = -1;
#pragma unroll
        for (int round = 0; round < 3; ++round) {
            float bv = g; int bi = lane;
#pragma unroll
            for (int o = 32; o >= 1; o >>= 1) { const float ov = __shfl_xor(bv, o); const int oi = __shfl_xor(bi, o); if (ov > bv || (ov == bv && oi < bi)) { bv = ov; bi = oi; } }
            if (bv > NEG) { if (round == 0) sb0 = bi; else if (round == 1) sb1 = bi; else sb2 = bi; if (lane == bi) g = NEG; }
        }
        float mloc = NEG;
#pragma unroll
        for (int slot = 0; slot < 4; ++slot) {
            const int n = slot == 0 ? sb0 : slot == 1 ? sb1 : slot == 2 ? sb2 : blk;
            for (int kk = 0; kk < 4; ++kk) { const int key = kk * 64 + lane; float sv = NEG;
                if (n >= 0) { const bf16_t* kr = Kg + ((size_t)b * SEQ + n * 256 + key) * DM + h * HD; float a = 0.f;
                    for (int c = 0; c < 16; ++c) { f32x4 x0, x1; unpack8(*(const u32x4*)(kr + 8 * c), x0, x1);
                        a += x0[0] * qs[8 * c] + x0[1] * qs[8 * c + 1] + x0[2] * qs[8 * c + 2] + x0[3] * qs[8 * c + 3] + x1[0] * qs[8 * c + 4] + x1[1] * qs[8 * c + 5] + x1[2] * qs[8 * c + 6] + x1[3] * qs[8 * c + 7]; }
                    sv = a; if (slot == 3 && key > (s & 255)) sv = NEG; }
                sc[slot * 256 + key] = sv; mloc = fmaxf(mloc, sv); }
        }
#pragma unroll
        for (int o = 32; o >= 1; o >>= 1) mloc = fmaxf(mloc, __shfl_xor(mloc, o));
        asm volatile("s_waitcnt lgkmcnt(0)" ::: "memory");
        float lsum = 0.f;
        for (int i = lane; i < 1024; i += 64) { const float p = exp2f(sc[i] - mloc); sc[i] = p; lsum += p; }
        lsum = wave_sum(lsum);
        asm volatile("s_waitcnt lgkmcnt(0)" ::: "memory");
        float a0 = 0.f, a1 = 0.f;
#pragma unroll
        for (int slot = 0; slot < 4; ++slot) {
            const int n = slot == 0 ? sb0 : slot == 1 ? sb1 : slot == 2 ? sb2 : blk;
            if (n < 0) continue;
            const bf16_t* vr = Vg + ((size_t)b * SEQ + n * 256) * DM + h * HD + 2 * lane;
            for (int key = 0; key < 256; ++key) { const float p = sc[slot * 256 + key]; const unsigned v = *(const unsigned*)(vr + (size_t)key * DM); a0 += p * bf_lo(v); a1 += p * bf_hi(v); }
        }
        const float o0 = a0 / lsum, o1 = a1 / lsum;
        const unsigned w = *(const unsigned*)(ATTN + rowoff + 2 * lane);
        float err = fmaxf(fabsf(o0 - bf_lo(w)), fabsf(o1 - bf_hi(w)));
        if (!(err == err)) err = 1e6f;
#pragma unroll
        for (int o = 32; o >= 1; o >>= 1) err = fmaxf(err, __shfl_xor(err, o));
        if (lane == 0) atomicMax(dbgmax, __float_as_uint(err));
        asm volatile("s_waitcnt lgkmcnt(0)" ::: "memory");
    }
}
#endif

__global__ void __launch_bounds__(NTHREADS, 2) mk_fwd(Args args) {
    extern __shared__ __attribute__((aligned(16))) unsigned char lds[];
    cg::grid_group grid = cg::this_grid();
    { volatile LAS unsigned* st0 = (volatile LAS unsigned*)((LAS unsigned char*)lds + LDS_MISC); if (threadIdx.x < 2) st0[threadIdx.x] = 0u; __syncthreads(); }
    const XcdBarrier xbar = xcd_barrier_post((unsigned*)(args.ws + WS_BAR), (volatile LAS unsigned*)((LAS unsigned char*)lds + LDS_MISC));
    if (args.use_cg) grid.sync();
#define GRID_BAR() xcd_barrier(xbar)
#ifndef PROBE_PHASE
#define PROBE_PHASE -1
#endif
#define PH_BEGIN(k) unsigned long long t0_ = 0; if (PROBE_PHASE == (k)) t0_ = __builtin_amdgcn_s_memrealtime()
#define PH_END(k) do { if (PROBE_PHASE == (k)) { const unsigned long long t1_ = __builtin_amdgcn_s_memrealtime(); while (__builtin_amdgcn_s_memrealtime() - t1_ < 2 * (t1_ - t0_)) __builtin_amdgcn_s_sleep(8); } } while (0)
    const int G = gridDim.x, bx = blockIdx.x;
#define TIDS() int tid = threadIdx.x; asm volatile("" : "+v"(tid)); const int lane = tid & 63, wave = __builtin_amdgcn_readfirstlane(tid >> 6); (void)lane; (void)wave
    const int vcu = (G % 8 == 0) ? (bx % 8) * (G / 8) + bx / 8 : bx;
#define OPQ(p) ((p) + opq0())
#define WSP(T, off) ((T*)(ws + (off)))
    LAS unsigned char* ldsl = (LAS unsigned char*)lds;

    {
        PH_BEGIN(0);
        TIDS();
        unsigned char* ws = OPQ(args.ws);
        const float* x = OPQ(args.in[0]); const float* g_mix = OPQ(args.in[1]); const float* w_in = OPQ(args.in[2]); const float* w_a = OPQ(args.in[4]); const float* w_c = OPQ(args.in[5]);
        const float* w_out = OPQ(args.in[6]); const float* g_ffn = OPQ(args.in[7]); const float* w_gu = OPQ(args.in[8]); const float* w_dn = OPQ(args.in[9]);
        bf16_t* WIN = WSP(bf16_t, WS_WIN); bf16_t* WAC = WSP(bf16_t, WS_WAC); bf16_t* WOUT = WSP(bf16_t, WS_WOUT); bf16_t* WGU = WSP(bf16_t, WS_WGU); bf16_t* WDN = WSP(bf16_t, WS_WDN);
        float* ROPEC = WSP(float, WS_ROPE); float* ROPES = ROPEC + SEQ * 16; bf16_t* U = WSP(bf16_t, WS_U);
        LAS float* scr = (LAS float*)(ldsl + wave * 16384);
        const int gw = vcu * 8 + wave, NGW = G * 8;
        constexpr int I_IN = 16 * 256, I_SQ = 16 * 32, I_GU = 16 * 176, I_DN = 44 * 32;
        constexpr int NITEMS = I_IN + 3 * I_SQ + I_GU + I_DN;
        for (int it = gw; it < NITEMS; it += NGW) {
            int r = it;
            if (r < I_IN) { const int kb = r >> 8, nb = r & 255; transpose_item(w_in, INW, WIN, DM, 64 * kb, 32 * nb, map_in(32 * nb), nullptr, scr, lane); continue; } r -= I_IN;
            if (r < I_SQ) { const int kb = r >> 5, nb = r & 31; transpose_item(w_a, DM, WAC, DM, 64 * kb, 32 * nb, 32 * nb, nullptr, scr, lane); continue; } r -= I_SQ;
            if (r < I_SQ) { const int kb = r >> 5, nb = r & 31; transpose_item(w_c, DM, WAC, DM, 64 * kb, 32 * nb, 1024 + 32 * nb, nullptr, scr, lane); continue; } r -= I_SQ;
            if (r < I_SQ) { const int kb = r >> 5, nb = r & 31; transpose_item(w_out, DM, WOUT, DM, 64 * kb, 32 * nb, 32 * nb, nullptr, scr, lane); continue; } r -= I_SQ;
            if (r < I_GU) { const int kb = r / 176, nb = r % 176; transpose_item(w_gu, 2 * DFF, WGU, DM, 64 * kb, 32 * nb, map_gu(32 * nb), g_ffn, scr, lane); continue; } r -= I_GU;
            { const int kb = r >> 5, nb = r & 31; transpose_item(w_dn, DM, WDN, DFF, 64 * kb, 32 * nb, 32 * nb, nullptr, scr, lane); }
        }
        for (int m = gw; m < MTOK; m += NGW) {
            const f32x4* xr = (const f32x4*)(x + (size_t)m * DM) + lane; const f32x4* gr = (const f32x4*)g_mix + lane;
            f32x4 v[4]; float s = 0.f;
#pragma unroll
            for (int j = 0; j < 4; ++j) { v[j] = xr[64 * j]; s += (v[j].x * v[j].x + v[j].y * v[j].y) + (v[j].z * v[j].z + v[j].w * v[j].w); }
            const float rstd = 1.0f / sqrtf(wave_sum(s) * (1.0f / DM) + EPS);
            u32x2* o8 = (u32x2*)(U + (size_t)m * DM) + lane;
#pragma unroll
            for (int j = 0; j < 4; ++j) { const f32x4 gg = gr[64 * j]; u32x2 w; w.x = cvt_pk_bf16(v[j].x * rstd * gg.x, v[j].y * rstd * gg.y); w.y = cvt_pk_bf16(v[j].z * rstd * gg.z, v[j].w * rstd * gg.w); o8[64 * j] = w; }
        }
        for (int idx = (vcu * NTHREADS + tid); idx < SEQ * 16; idx += G * NTHREADS) {
            const int pos = idx >> 4, i = idx & 15;
            const double f = exp2(-(double)i * (18.931568569324174 / 16.0));
            const double a = (double)pos * f;
            ROPEC[idx] = (float)cos(a); ROPES[idx] = (float)sin(a);
        }
        PH_END(0);
    }
    GRID_BAR();

    {
        PH_BEGIN(1);
        unsigned char* ws = OPQ(args.ws); unsigned char* outb = (unsigned char*)OPQ(args.out);
        float* ROPEC = WSP(float, WS_ROPE);
        pg8::Gemm g{WSP(bf16_t, WS_U), WSP(bf16_t, WS_U), 1 << 30, WSP(bf16_t, WS_WIN), MTOK, INW, DM}; pg8::StaticOrder S; S.init(MTOK, INW, G, bx);
        pg8::EpiIn E{(bf16_t*)outb, (bf16_t*)(outb + 32 * MiB), WSP(bf16_t, WS_V), WSP(bf16_t, WS_P), WSP(bf16_t, WS_BG), WSP(bf16_t, WS_SGA), WSP(bf16_t, WS_SGC), WSP(float, WS_KM), ROPEC, ROPEC + SEQ * 16};
        pg8::gemm_phase<pg8::EpiIn, pg8::StaticOrder, true, true>(ldsl, g, S, E);
        PH_END(1);
    }
    GRID_BAR();

    {
        PH_BEGIN(2);
        TIDS();
        unsigned char* ws = OPQ(args.ws); unsigned char* outb = (unsigned char*)OPQ(args.out); const float* conv_w = OPQ(args.in[3]);
        bf16_t* PB = WSP(bf16_t, WS_P); bf16_t* BG = WSP(bf16_t, WS_BG); bf16_t* CZ = WSP(bf16_t, WS_U);
        bf16_t* QB_ = (bf16_t*)outb; bf16_t* KB_ = (bf16_t*)(outb + 32 * MiB); bf16_t* VB_ = WSP(bf16_t, WS_V); float* KM = WSP(float, WS_KM);
        for (int w = vcu * NTHREADS + tid; w < 128 * (MTOK / 16); w += G * NTHREADS) {
            const int cgp = w & 127, rc = w >> 7, c0 = cgp * 8, row0 = rc * 16;
            f32x4 w0a = *(const f32x4*)(conv_w + c0), w0b = *(const f32x4*)(conv_w + c0 + 4);
            f32x4 w1a = *(const f32x4*)(conv_w + DM + c0), w1b = *(const f32x4*)(conv_w + DM + c0 + 4);
            f32x4 w2a = *(const f32x4*)(conv_w + 2 * DM + c0), w2b = *(const f32x4*)(conv_w + 2 * DM + c0 + 4);
            f32x4 m2a = {0.f, 0.f, 0.f, 0.f}, m2b = m2a, m1a = m2a, m1b = m2a;
            if ((row0 & (SEQ - 1)) != 0) { unpack8(*(const u32x4*)(PB + (size_t)(row0 - 2) * DM + c0), m2a, m2b); unpack8(*(const u32x4*)(PB + (size_t)(row0 - 1) * DM + c0), m1a, m1b); }
#pragma unroll 4
            for (int r = 0; r < 16; ++r) { const size_t o = (size_t)(row0 + r) * DM + c0;
                f32x4 pa, pb, ba, bb; unpack8(*(const u32x4*)(PB + o), pa, pb); unpack8(*(const u32x4*)(BG + o), ba, bb);
                const f32x4 ya = ba * (w0a * m2a + w1a * m1a + w2a * pa), yb = bb * (w0b * m2b + w1b * m1b + w2b * pb);
                *(u32x4*)(CZ + o) = pack8u(ya, yb);
                m2a = m1a; m2b = m1b; m1a = pa; m1b = pb; }
        }
        for (int item = vcu; item < 256; item += G) {
            const int bh = item >> 4, sq = item & 15, b = bh >> 3, h = bh & 7; const size_t base = (size_t)b * SEQ * DM + h * HD;
#pragma unroll 1
            for (int pass = 0; pass < 2; ++pass)
                att::gate_lists(QB_ + base, KM + (size_t)bh * NKB * HD, pass ? 31 - sq : sq, WSP(unsigned, WS_CNT) + bh * 32, WSP(unsigned short, WS_LIST) + (size_t)bh * LIST_PER_BH);
        }
#if DBG_ATTN
        { const u32x4* src = (const u32x4*)QB_; u32x4* dst = (u32x4*)WSP(bf16_t, WS_SGA);
          for (size_t i = (size_t)vcu * NTHREADS + tid; i < (size_t)MTOK * DM / 8; i += (size_t)G * NTHREADS) dst[i] = src[i]; }
#endif
        PH_END(2);
    }
    GRID_BAR();

    {
        PH_BEGIN(8);
        TIDS();
        unsigned char* ws = OPQ(args.ws); unsigned char* outb = (unsigned char*)OPQ(args.out);
        bf16_t* QB_ = (bf16_t*)outb; bf16_t* KB_ = (bf16_t*)(outb + 32 * MiB); bf16_t* VB_ = WSP(bf16_t, WS_V);
        LAS unsigned* c_l = (LAS unsigned*)(ldsl + att::LDS_STAGE); LAS unsigned* pre_l = c_l + 512;
        if (tid < 512) c_l[tid] = __hip_atomic_load(WSP(unsigned, WS_CNT) + tid, __ATOMIC_RELAXED, __HIP_MEMORY_SCOPE_AGENT);
        __syncthreads();
        if (wave == 0) {
            unsigned v[8], sum = 0u;
#pragma unroll
            for (int i = 0; i < 8; ++i) { v[i] = (c_l[8 * lane + i] + 255u) >> 8; sum += v[i]; }
            unsigned inc = sum;
#pragma unroll
            for (int o = 1; o < 64; o <<= 1) { const unsigned t = __shfl_up(inc, o); if (lane >= o) inc += t; }
            unsigned run = inc - sum;
#pragma unroll
            for (int i = 0; i < 8; ++i) { pre_l[8 * lane + i] = run; run += v[i]; }
            if (lane == 63) pre_l[512] = inc;
        }
        __syncthreads();
        const int T = (int)pre_l[512];
        if (vcu < T) {
            auto mkitem = [&](int k) { int lo = 0, hi = 512;
                while (hi - lo > 1) { const int mid = (lo + hi) >> 1; if ((int)pre_l[mid] <= k) lo = mid; else hi = mid; }
                const int e = __builtin_amdgcn_readfirstlane(lo), c = k - (int)pre_l[e], bh = e >> 5, n = e & 31, b = bh >> 3, h = bh & 7, left = (int)c_l[e] - 256 * c;
                att::BlockRef r; const size_t base = (size_t)b * SEQ * DM + h * HD;
                r.Qb = QB_ + base; r.K = KB_ + base + (size_t)n * 256 * DM; r.V = VB_ + base + (size_t)n * 256 * DM;
                r.list = WSP(unsigned short, WS_LIST) + (size_t)bh * LIST_PER_BH + att::list_off(n) + 256 * c; r.nrows = __builtin_amdgcn_readfirstlane(left < 256 ? left : 256); r.qb = 0; r.O = nullptr;
                const unsigned hb = (unsigned)(h * HD * 2), bo = (unsigned)b * (unsigned)(SEQ * DM * 2);
                r.po0 = (unsigned)WS_PO0 + bo + hb; r.po2 = (b ? (unsigned)WS_PO2B : (unsigned)WS_PO2A) + hb;
                r.lo0 = (unsigned)WS_LSE + (unsigned)(bh * SEQ * 4); return r; };
            att::Seam S; att::BlockRef cur = mkitem(vcu);
            att::attn_prime<0>(cur, (char*)lds, S);
            for (int k = vcu; k < T; k += G) {
                const att::BlockRef nxt = (k + G < T) ? mkitem(k + G) : cur;
                att::attn_block<0>(cur, nxt, (char*)lds, S, ws);
                cur = nxt;
            }
        }
        PH_END(8);
    }
    GRID_BAR();

    {
        PH_BEGIN(9);
        unsigned char* ws = OPQ(args.ws); unsigned char* outb = (unsigned char*)OPQ(args.out);
        bf16_t* QB_ = (bf16_t*)outb; bf16_t* KB_ = (bf16_t*)(outb + 32 * MiB); bf16_t* VB_ = WSP(bf16_t, WS_V);
        if (vcu < 256) {
            const int nblocks = 2 * ((256 - vcu + G - 1) / G);
            auto mkref = [&](int k) { const int item = vcu + (k >> 1) * G, bh = item >> 4, sq = item & 15, b = bh >> 3, h = bh & 7;
                att::BlockRef r; const size_t base = (size_t)b * SEQ * DM + h * HD; r.qb = (k & 1) ? 31 - sq : sq;
                r.Qb = QB_ + base; r.K = KB_ + base + (size_t)r.qb * 256 * DM; r.V = VB_ + base + (size_t)r.qb * 256 * DM; r.O = QB_ + base; r.list = nullptr; r.nrows = 256;
                const unsigned hb = (unsigned)(h * HD * 2), bo = (unsigned)b * (unsigned)(SEQ * DM * 2);
                r.po0 = (unsigned)WS_PO0 + bo + hb; r.po2 = (b ? (unsigned)WS_PO2B : (unsigned)WS_PO2A) + hb;
                r.lo0 = (unsigned)WS_LSE + (unsigned)(bh * SEQ * 4); return r; };
            att::Seam S; att::BlockRef cur = mkref(0);
            att::attn_prime<1>(cur, (char*)lds, S);
            for (int k = 0; k < nblocks; ++k) {
                const att::BlockRef nxt = (k + 1 < nblocks) ? mkref(k + 1) : cur;
                att::attn_block<1>(cur, nxt, (char*)lds, S, ws);
                cur = nxt;
            }
        }
        PH_END(9);
    }
    GRID_BAR();

#if DBG_ATTN
    {
        TIDS();
        unsigned char* ws = OPQ(args.ws); unsigned char* outb = (unsigned char*)OPQ(args.out); float* out = OPQ(args.out);
        unsigned* dbgmax = (unsigned*)(ws + 65536);
        dbg_check(WSP(bf16_t, WS_SGA), (const bf16_t*)(outb + 32 * MiB), WSP(bf16_t, WS_V), (const bf16_t*)outb, WSP(float, WS_KM), dbgmax, ldsl, vcu * 8 + wave, G * 8, lane, wave);
        GRID_BAR();
        const float e = __uint_as_float(__hip_atomic_load(dbgmax, __ATOMIC_RELAXED, __HIP_MEMORY_SCOPE_AGENT));
        GRID_BAR();
        for (size_t i = (size_t)vcu * NTHREADS + tid; i < (size_t)MTOK * DM / 4; i += (size_t)G * NTHREADS) ((f32x4*)out)[i] = (f32x4){0.f, 0.f, 0.f, 0.f};
        GRID_BAR();
        if (bx == 0 && tid == 0) out[0] = 1.0e4f * e;
        return;
    }
#endif
    {
        PH_BEGIN(3);
        unsigned char* ws = OPQ(args.ws); unsigned char* outb = (unsigned char*)OPQ(args.out);
        pg8::Gemm g{(bf16_t*)outb, WSP(bf16_t, WS_U), 64, WSP(bf16_t, WS_WAC), 2 * MTOK, 2 * DM, DM}; pg8::BranchOrder S; S.s.init(MTOK, DM, G, bx);
        pg8::EpiBranch E{WSP(bf16_t, WS_SGA), WSP(bf16_t, WS_SGC), WSP(float, WS_T), WSP(bf16_t, WS_MG)};
        pg8::gemm_phase<pg8::EpiBranch, pg8::BranchOrder, true, true>(ldsl, g, S, E);
        PH_END(3);
    }
    GRID_BAR();

    {
        PH_BEGIN(4);
        unsigned char* ws = OPQ(args.ws);
        pg8::Gemm g{WSP(bf16_t, WS_MG), WSP(bf16_t, WS_MG), 1 << 30, WSP(bf16_t, WS_WOUT), MTOK, DM, DM}; pg8::StaticOrder S; S.init(MTOK, DM, G, bx);
        pg8::EpiH1 E{OPQ(args.in[0]), OPQ(args.out), WSP(bf16_t, WS_H1B), WSP(float, WS_SSQ1)};
        pg8::gemm_phase<pg8::EpiH1, pg8::StaticOrder, true, true>(ldsl, g, S, E);
        PH_END(4);
    }
    GRID_BAR();

    {
        PH_BEGIN(5);
        unsigned char* ws = OPQ(args.ws);
        pg8::Gemm g{WSP(bf16_t, WS_H1B), WSP(bf16_t, WS_H1B), 1 << 30, WSP(bf16_t, WS_WGU), MTOK, 2 * DFF, DM}; pg8::StaticOrder S; S.init(MTOK, 2 * DFF, G, bx);
        pg8::EpiSwiglu E{WSP(float, WS_SSQ1), WSP(bf16_t, WS_HFF)};
        pg8::gemm_phase<pg8::EpiSwiglu, pg8::StaticOrder, true, true>(ldsl, g, S, E);
        PH_END(5);
    }
    GRID_BAR();

    {
        PH_BEGIN(6);
        unsigned char* ws = OPQ(args.ws);
        pg8::Gemm g{WSP(bf16_t, WS_HFF), WSP(bf16_t, WS_HFF), 1 << 30, WSP(bf16_t, WS_WDN), MTOK, DM, DFF}; pg8::StaticOrder S; S.init(MTOK, DM, G, bx);
        pg8::EpiDown E{OPQ(args.out), WSP(float, WS_SSQ2)};
        pg8::gemm_phase<pg8::EpiDown, pg8::StaticOrder, true, true>(ldsl, g, S, E);
        PH_END(6);
    }
    GRID_BAR();

    {
        PH_BEGIN(7);
        TIDS();
        unsigned char* ws = OPQ(args.ws); float* out = OPQ(args.out); const float* g_final = OPQ(args.in[10]); const float* SSQ2 = WSP(float, WS_SSQ2);
        const int gw = vcu * 8 + wave, NGW = G * 8;
        for (int m = gw; m < MTOK; m += NGW) {
            f32x4* xr = (f32x4*)(out + (size_t)m * DM) + lane; const f32x4* gr = (const f32x4*)g_final + lane;
            const float rstd = 1.0f / sqrtf(SSQ2[m] * (1.0f / DM) + EPS);
#pragma unroll
            for (int j = 0; j < 4; ++j) { const f32x4 v = xr[64 * j], gg = gr[64 * j]; xr[64 * j] = v * rstd * gg; }
        }
        PH_END(7);
    }
}

extern "C" void kernel_launch(void* const* d_in, const int* in_sizes, int n_in, void* d_out, int out_size, void* d_ws, size_t ws_size, hipStream_t stream) {
    static int grid = 0;
    if (grid == 0) {
        if (n_in != 11 || out_size != MTOK * DM || ws_size < WS_END) { fprintf(stderr, "kernel_launch: unexpected shapes (n_in %d out %d ws %zu)\n", n_in, out_size, ws_size); grid = -1; return; }
        int dev = 0, cus = 0, per_cu = 0;
        (void)hipGetDevice(&dev); (void)hipDeviceGetAttribute(&cus, hipDeviceAttributeMultiprocessorCount, dev);
        if (hipFuncSetAttribute((const void*)mk_fwd, hipFuncAttributeMaxDynamicSharedMemorySize, LDS_BYTES) != hipSuccess) { fprintf(stderr, "kernel_launch: hipFuncSetAttribute failed\n"); grid = -1; return; }
        if (hipOccupancyMaxActiveBlocksPerMultiprocessor(&per_cu, (const void*)mk_fwd, NTHREADS, LDS_BYTES) != hipSuccess || per_cu < 1) { fprintf(stderr, "kernel_launch: occupancy query failed (%d)\n", per_cu); grid = -1; return; }
        grid = cus * per_cu;
        if (grid > 256) grid = 256;
        grid &= ~7;
        fprintf(stderr, "kernel_launch: cus %d per_cu %d grid %d\n", cus, per_cu, grid);
    }
    if (grid <= 0) return;
    (void)hipMemsetAsync((char*)d_ws + WS_CTL, 0, CTL_ZERO_BYTES, stream);
    Args a{};
    for (int i = 0; i < 11; ++i) a.in[i] = (const float*)d_in[i];
    a.out = (float*)d_out; a.ws = (unsigned char*)d_ws; a.use_cg = 0; a.pad = 0;
    void* kargs[] = {&a};
    hipError_t e = hipLaunchCooperativeKernel((const void*)mk_fwd, dim3(grid), dim3(NTHREADS), kargs, LDS_BYTES, stream);
    if (e != hipSuccess) fprintf(stderr, "kernel_launch: cooperative launch failed: %s (grid %d)\n", hipGetErrorString(e), grid);
}
```

```cpp
#include <hip/hip_runtime.h>
#include <hip/hip_cooperative_groups.h>
#include <cstdio>
#include <cstdint>
namespace cg = cooperative_groups;

#define LAS __attribute__((address_space(3)))
typedef unsigned short bf16_t;
typedef short bf16x8 __attribute__((ext_vector_type(8)));
typedef short s16x4 __attribute__((ext_vector_type(4)));
typedef float f32x2 __attribute__((ext_vector_type(2)));
typedef float f32x4 __attribute__((ext_vector_type(4)));
typedef float f32x16 __attribute__((ext_vector_type(16)));
typedef unsigned u32x2 __attribute__((ext_vector_type(2)));
typedef unsigned u32x4 __attribute__((ext_vector_type(4)));

constexpr int BATCH = 2, SEQ = 8192, DM = 1024, MTOK = BATCH * SEQ, NHEAD = 8, HD = 128, NKB = SEQ / 256, DFF = 2816, INW = 8192;
constexpr float EPS = 1e-6f;
constexpr float QSCALE = 0.08838834764831845f * 1.4426950408889634f;

__device__ __forceinline__ unsigned cvt_pk_bf16(float lo, float hi) { unsigned r; asm volatile("v_cvt_pk_bf16_f32 %0, %1, %2" : "=v"(r) : "v"(lo), "v"(hi)); return r; }
__device__ __forceinline__ u32x4 pack8u(f32x4 a, f32x4 b) { u32x4 w; w.x = cvt_pk_bf16(a[0], a[1]); w.y = cvt_pk_bf16(a[2], a[3]); w.z = cvt_pk_bf16(b[0], b[1]); w.w = cvt_pk_bf16(b[2], b[3]); return w; }
__device__ __forceinline__ float bf_lo(unsigned w) { return __uint_as_float(w << 16); }
__device__ __forceinline__ float bf_hi(unsigned w) { return __uint_as_float(w & 0xffff0000u); }
__device__ __forceinline__ void unpack8(u32x4 w, f32x4& a, f32x4& b) { a = (f32x4){bf_lo(w.x), bf_hi(w.x), bf_lo(w.y), bf_hi(w.y)}; b = (f32x4){bf_lo(w.z), bf_hi(w.z), bf_lo(w.w), bf_hi(w.w)}; }
__device__ __forceinline__ float sigmoidf_(float x) { return 1.0f / (1.0f + __expf(-x)); }

namespace pg8 {
constexpr int BM = 256, BK = 64, HALF = 128, HTB = HALF * BK * 2, STAGE_BYTES = 8 * HTB, NXCD = 8, WGM = 8;
__host__ __device__ __forceinline__ int lds_byte(int r, int c) { const int st = (r >> 4) * 2 + (c >> 5), rr = r & 15, cc = c & 31, ob = rr * 64 + cc * 2; return st * 1024 + (ob ^ (((ob >> 9) & 1) << 5)); }
__host__ __device__ __forceinline__ void stage_rc(int b, int& R, int& C) { const int st = b / 1024, sb = b % 1024, swz = sb ^ (((sb >> 9) & 1) << 5); R = (st >> 1) * 16 + swz / 64; C = (st & 1) * 32 + (swz % 64) / 2; }
__host__ __device__ __forceinline__ int perm32(int rho) { const int n = rho >> 4, i = rho & 15; return 8 * (i >> 2) + 4 * n + (i & 3); }

struct Unit { int pm, pn; };
struct Gemm { const bf16_t* A; const bf16_t* A2; int pmsplit; const bf16_t* Bt; int M, N, K; };

struct StaticOrder {
    int nM, nN, nwg, G, c;
    __host__ __device__ void init(int M, int N, int G_, int c_) { nM = M / BM; nN = N / BM; nwg = nM * nN; G = G_; c = c_; }
    __host__ __device__ bool next(int i, Unit& u) const {
        const long L = (long)i * G + c; if (L >= nwg) return false;
        int wgid = (int)L; { const int q = nwg / NXCD, r = nwg % NXCD, xcd = wgid % NXCD, off = wgid / NXCD; wgid = (xcd < r ? xcd * (q + 1) : r * (q + 1) + (xcd - r) * q) + off; }
        const int nig = WGM * nN, gid = wgid / nig, fm = gid * WGM, gsz = (nM - fm) < WGM ? (nM - fm) : WGM;
        u.pm = fm + ((wgid % nig) % gsz); u.pn = (wgid % nig) / gsz; return true;
    }
    __device__ __forceinline__ void a_ready(const Unit&) const {}
    __device__ __forceinline__ void done(const Unit&) const {}
};
struct BranchOrder {
    StaticOrder s;
    __device__ bool next(int i, Unit& u) const { if (!s.next(i >> 1, u)) return false; if (i & 1) { u.pm += 64; u.pn += 4; } return true; }
    __device__ __forceinline__ void a_ready(const Unit&) const {}
    __device__ __forceinline__ void done(const Unit&) const {}
};

template <class Epi, class Sched, bool ALIGN_EPI = false, bool SP2 = false>
__device__ __forceinline__ void gemm_phase(LAS unsigned char* lds, const Gemm g, const Sched& S, const Epi& E) {
    int tid = threadIdx.x; asm volatile("" : "+v"(tid));
    const int wid = __builtin_amdgcn_readfirstlane(tid >> 6), lane = tid & 63, wr = wid >> 2, wc = wid & 3, fr = lane & 15, fq = lane >> 4;
    const int K = g.K, nt = K / BK;
    unsigned voffA[2], voffB[2];
#pragma unroll
    for (int i = 0; i < 2; ++i) { int R, C; stage_rc(tid * 16 + i * 8192, R, C); const int Rb = Epi::PERM ? ((R & ~31) + perm32(R & 31)) : R;
        voffA[i] = (unsigned)(R * K + C) * 2u; voffB[i] = (unsigned)(Rb * K + C) * 2u; }
    const size_t kstep = (size_t)(BK * 2);
    const size_t hstep = (size_t)HALF * K * 2;
    const size_t tstep = 2 * hstep;
    const unsigned ldsw = (unsigned)wid * 1024u;
    const int aoff = lds_byte(wr * 64 + fr, fq * 8), boff = lds_byte(wc * 32 + fr, fq * 8);
#define PG8_APTR(pm_) ((pm_) < g.pmsplit ? (const char*)g.A + (size_t)(pm_) * tstep : (const char*)g.A2 + (size_t)((pm_) - g.pmsplit) * tstep)
#define PG8_SA(b, h) (((b) * 2 + (h)) * HTB)
#define PG8_SB(b, h) ((4 + (b) * 2 + (h)) * HTB)
#define PG8_STAGE(bufoff, gbase, voff) do { _Pragma("unroll") for (int _i = 0; _i < 2; ++_i) \
        __builtin_amdgcn_global_load_lds((const unsigned*)((const char*)(gbase) + (voff)[_i]), (LAS unsigned*)(lds + (bufoff) + ldsw + _i * 8192), 16, 0, 0); } while (0)
#define PG8_LDA(dst, b, h) do { _Pragma("unroll") for (int m = 0; m < 4; ++m) _Pragma("unroll") for (int k = 0; k < 2; ++k) dst[m][k] = *(const LAS bf16x8*)(lds + PG8_SA(b, h) + aoff + m * 2048 + k * 1024); } while (0)
#define PG8_LDB(dst, b, h) do { _Pragma("unroll") for (int n = 0; n < 2; ++n) _Pragma("unroll") for (int k = 0; k < 2; ++k) dst[n][k] = *(const LAS bf16x8*)(lds + PG8_SB(b, h) + boff + n * 2048 + k * 1024); } while (0)
#define PG8_MMA(ai, bj, At, Bt) do { __builtin_amdgcn_s_setprio(1); _Pragma("unroll") for (int m = 0; m < 4; ++m) _Pragma("unroll") for (int n = 0; n < 2; ++n) _Pragma("unroll") for (int k = 0; k < 2; ++k) \
        acc[ai][bj][m][n] = __builtin_amdgcn_mfma_f32_16x16x32_bf16(Bt[n][k], At[m][k], acc[ai][bj][m][n], 0, 0, 0); __builtin_amdgcn_s_setprio(0); } while (0)
#define PG8_WAIT_V(n) asm volatile("s_waitcnt vmcnt(" #n ")" ::: "memory")
#define PG8_WAIT_L(n) asm volatile("s_waitcnt lgkmcnt(" #n ")" ::: "memory")
#define PG8_BAR __builtin_amdgcn_s_barrier()
#define PG8_SCHED __builtin_amdgcn_sched_barrier(0)
    Unit cur, nxt; int ui = 0;
    if (!S.next(0, cur)) return;
    f32x4 acc[2][2][4][2];
#pragma unroll
    for (int a = 0; a < 2; ++a)
#pragma unroll
        for (int b = 0; b < 2; ++b)
#pragma unroll
            for (int m = 0; m < 4; ++m)
#pragma unroll
                for (int n = 0; n < 2; ++n) acc[a][b][m][n] = (f32x4){0.f, 0.f, 0.f, 0.f};
    bf16x8 At[4][2], B0[2][2], B1[2][2];
    const char* cA = PG8_APTR(cur.pm); const char* cB = (const char*)g.Bt + (size_t)cur.pn * tstep;
    S.a_ready(cur);
    if constexpr (SP2) {
        PG8_STAGE(PG8_SB(0, 0), cB, voffB); PG8_STAGE(PG8_SB(0, 1), cB + hstep, voffB); PG8_STAGE(PG8_SA(0, 0), cA, voffA); PG8_STAGE(PG8_SA(0, 1), cA + hstep, voffA);
        if (wr == 1) PG8_BAR;
        PG8_WAIT_V(2); PG8_BAR;
        PG8_STAGE(PG8_SB(1, 0), cB + kstep, voffB); PG8_STAGE(PG8_SA(1, 0), cA + kstep, voffA); PG8_STAGE(PG8_SB(1, 1), cB + hstep + kstep, voffB);
        PG8_WAIT_V(6); PG8_BAR;
    } else {
        PG8_STAGE(PG8_SB(0, 0), cB, voffB); PG8_STAGE(PG8_SA(0, 0), cA, voffA); PG8_STAGE(PG8_SB(0, 1), cB + hstep, voffB); PG8_STAGE(PG8_SA(0, 1), cA + hstep, voffA);
        if (wr == 1) PG8_BAR;
        PG8_WAIT_V(4); PG8_BAR;
        PG8_STAGE(PG8_SB(1, 0), cB + kstep, voffB); PG8_STAGE(PG8_SA(1, 0), cA + kstep, voffA); PG8_STAGE(PG8_SB(1, 1), cB + hstep + kstep, voffB);
        PG8_WAIT_V(6); PG8_BAR;
    }
    for (;;) {
        const bool has_next = S.next(ui + 1, nxt);
        const char* nA = has_next ? PG8_APTR(nxt.pm) : cA; const char* nB = has_next ? (const char*)g.Bt + (size_t)nxt.pn * tstep : cB;
        for (int t = 0; t < nt; t += 2) {
            const bool last = (t == nt - 2);
            const char* a1 = cA + (size_t)(t + 1) * kstep;
            const char* a2 = last ? nA : cA + (size_t)(t + 2) * kstep; const char* b2 = last ? nB : cB + (size_t)(t + 2) * kstep;
            const char* a3 = a2 + kstep; const char* b3 = b2 + kstep;
            if (last && has_next) S.a_ready(nxt);
            if constexpr (SP2) {
            PG8_LDB(B0, 0, 0); PG8_LDB(B1, 0, 1); PG8_SCHED; PG8_LDA(At, 0, 0); PG8_STAGE(PG8_SA(1, 1), a1 + hstep, voffA);
            PG8_WAIT_V(8); PG8_WAIT_L(0); PG8_BAR; PG8_MMA(0, 0, At, B0); PG8_MMA(0, 1, At, B1); PG8_BAR; PG8_SCHED;
            PG8_LDA(At, 0, 1); PG8_STAGE(PG8_SB(0, 0), b2, voffB); PG8_STAGE(PG8_SB(0, 1), b2 + hstep, voffB); PG8_STAGE(PG8_SA(0, 0), a2, voffA);
            PG8_WAIT_V(8); PG8_WAIT_L(0); PG8_BAR; PG8_MMA(1, 0, At, B0); PG8_MMA(1, 1, At, B1); PG8_BAR; PG8_SCHED;
            PG8_LDB(B0, 1, 0); PG8_LDB(B1, 1, 1); PG8_SCHED; PG8_LDA(At, 1, 0); PG8_STAGE(PG8_SA(0, 1), a2 + hstep, voffA);
            PG8_WAIT_V(8); PG8_WAIT_L(0); PG8_BAR; PG8_MMA(0, 0, At, B0); PG8_MMA(0, 1, At, B1); PG8_BAR; PG8_SCHED;
            PG8_LDA(At, 1, 1); PG8_STAGE(PG8_SB(1, 0), b3, voffB); PG8_STAGE(PG8_SB(1, 1), b3 + hstep, voffB); PG8_STAGE(PG8_SA(1, 0), a3, voffA);
            PG8_WAIT_V(8); PG8_WAIT_L(0); PG8_BAR; PG8_MMA(1, 0, At, B0); PG8_MMA(1, 1, At, B1); PG8_BAR; PG8_SCHED;
            } else {
            PG8_LDB(B0, 0, 0); PG8_SCHED; PG8_LDA(At, 0, 0); PG8_STAGE(PG8_SA(1, 1), a1 + hstep, voffA);
            PG8_WAIT_L(8); PG8_BAR; PG8_WAIT_L(0); PG8_MMA(0, 0, At, B0); PG8_BAR; PG8_SCHED;
            PG8_LDB(B1, 0, 1); PG8_STAGE(PG8_SB(0, 0), b2, voffB);
            PG8_BAR; PG8_WAIT_L(0); PG8_MMA(0, 1, At, B1); PG8_BAR;
            PG8_LDA(At, 0, 1); PG8_STAGE(PG8_SA(0, 0), a2, voffA);
            PG8_BAR; PG8_WAIT_L(0); PG8_MMA(1, 0, At, B0); PG8_BAR; PG8_SCHED;
            PG8_STAGE(PG8_SB(0, 1), b2 + hstep, voffB);
            PG8_WAIT_V(6); PG8_BAR; PG8_MMA(1, 1, At, B1); PG8_BAR;
            PG8_LDB(B0, 1, 0); PG8_SCHED; PG8_LDA(At, 1, 0); PG8_STAGE(PG8_SA(0, 1), a2 + hstep, voffA);
            PG8_WAIT_L(8); PG8_BAR; PG8_WAIT_L(0); PG8_MMA(0, 0, At, B0); PG8_BAR; PG8_SCHED;
            PG8_LDB(B1, 1, 1); PG8_STAGE(PG8_SB(1, 0), b3, voffB);
            PG8_BAR; PG8_WAIT_L(0); PG8_MMA(0, 1, At, B1); PG8_BAR;
            PG8_LDA(At, 1, 1); PG8_STAGE(PG8_SA(1, 0), a3, voffA);
            PG8_BAR; PG8_WAIT_L(0); PG8_MMA(1, 0, At, B0); PG8_BAR; PG8_SCHED;
            PG8_STAGE(PG8_SB(1, 1), b3 + hstep, voffB);
            PG8_WAIT_V(6); PG8_BAR; PG8_MMA(1, 1, At, B1); PG8_BAR;
            }
        }
        if constexpr (ALIGN_EPI) { if (wr == 0) PG8_BAR; }
        E(acc, cur, wr, wc, fr, fq); S.done(cur);
        if (!has_next) break;
#pragma unroll
        for (int a = 0; a < 2; ++a)
#pragma unroll
            for (int b = 0; b < 2; ++b)
#pragma unroll
                for (int m = 0; m < 4; ++m)
#pragma unroll
                    for (int n = 0; n < 2; ++n) acc[a][b][m][n] = (f32x4){0.f, 0.f, 0.f, 0.f};
        cur = nxt; cA = nA; cB = nB; ++ui;
        if constexpr (ALIGN_EPI) { if (wr == 1) PG8_BAR; }
    }
    PG8_WAIT_V(0);
    if constexpr (!ALIGN_EPI) { if (wr == 0) PG8_BAR; }
    PG8_BAR;
#undef PG8_APTR
#undef PG8_SA
#undef PG8_SB
#undef PG8_STAGE
#undef PG8_LDA
#undef PG8_LDB
#undef PG8_MMA
#undef PG8_WAIT_V
#undef PG8_WAIT_L
#undef PG8_BAR
#undef PG8_SCHED
}

struct EpiIn {
    static constexpr bool PERM = true;
    bf16_t *Q, *K, *V, *P, *BG, *SGA, *SGC; float* KM; const float* RC; const float* RS;
    __device__ __forceinline__ void operator()(const f32x4 (&acc)[2][2][4][2], const Unit& u, int wr, int wc, int fr, int fq) const {
        const int pn = u.pn, row0 = u.pm * BM + wr * 64 + fr, cw = wc * 32 + 8 * fq;
        if (pn < 8) {
            const bool isq = pn < 4; bf16_t* O = (isq ? Q : K) + (pn & 3) * 256 + cw;
            const float sgn = fq < 2 ? -1.f : 1.f;
            float ks[2][2][4];
#pragma unroll
            for (int bj = 0; bj < 2; ++bj)
#pragma unroll
                for (int n = 0; n < 2; ++n)
#pragma unroll
                    for (int e = 0; e < 4; ++e) ks[bj][n][e] = 0.f;
#pragma unroll
            for (int ai = 0; ai < 2; ++ai)
#pragma unroll
                for (int m = 0; m < 4; ++m) {
                    const int row = row0 + ai * HALF + m * 16, pos = row & (SEQ - 1);
                    f32x4 c0 = {1.f, 1.f, 1.f, 1.f}, c1 = c0, s0 = {0.f, 0.f, 0.f, 0.f}, s1 = s0;
                    if (wc == 0) { const float* rc = RC + pos * 16 + 8 * (fq & 1); const float* rs = RS + pos * 16 + 8 * (fq & 1);
                        c0 = *(const f32x4*)rc; c1 = *(const f32x4*)(rc + 4); s0 = *(const f32x4*)rs; s1 = *(const f32x4*)(rs + 4); }
#pragma unroll
                    for (int bj = 0; bj < 2; ++bj) {
                        f32x4 v0 = acc[ai][bj][m][0], v1 = acc[ai][bj][m][1];
                        if (wc == 0) {
                            f32x4 p0, p1;
#pragma unroll
                            for (int e = 0; e < 4; ++e) { p0[e] = __shfl_xor(v0[e], 32); p1[e] = __shfl_xor(v1[e], 32); }
                            v0 = v0 * c0 + (p0 * s0) * sgn; v1 = v1 * c1 + (p1 * s1) * sgn;
                        }
                        if (isq) { v0 = v0 * QSCALE; v1 = v1 * QSCALE; }
                        else {
#pragma unroll
                            for (int e = 0; e < 4; ++e) { ks[bj][0][e] += v0[e]; ks[bj][1][e] += v1[e]; } }
                        *(u32x4*)(O + (size_t)row * DM + bj * HALF) = pack8u(v0, v1);
                    }
                }
            if (!isq) {
                float* kmb = KM + ((size_t)((u.pm >> 5) * NHEAD + 2 * (pn & 3)) * NKB + (u.pm & 31)) * HD + cw;
#pragma unroll
                for (int bj = 0; bj < 2; ++bj)
#pragma unroll
                    for (int n = 0; n < 2; ++n)
#pragma unroll
                        for (int e = 0; e < 4; ++e) { float v = ks[bj][n][e];
                            v += __shfl_xor(v, 1); v += __shfl_xor(v, 2); v += __shfl_xor(v, 4); v += __shfl_xor(v, 8);
                            if (fr == 0) atomicAdd(kmb + (size_t)bj * NKB * HD + 4 * n + e, v); }
            }
        } else if (pn < 12 || (pn >= 20 && pn < 24)) {
            bf16_t* O = (pn < 12 ? V + (pn - 8) * 256 : BG + (pn - 20) * 256) + cw;
#pragma unroll
            for (int ai = 0; ai < 2; ++ai)
#pragma unroll
                for (int m = 0; m < 4; ++m) { const int row = row0 + ai * HALF + m * 16;
#pragma unroll
                    for (int bj = 0; bj < 2; ++bj) *(u32x4*)(O + (size_t)row * DM + bj * HALF) = pack8u(acc[ai][bj][m][0], acc[ai][bj][m][1]); }
        } else if (pn < 20) {
            bf16_t* O = P + (pn - 12) * 128 + cw;
#pragma unroll
            for (int ai = 0; ai < 2; ++ai)
#pragma unroll
                for (int m = 0; m < 4; ++m) { const int row = row0 + ai * HALF + m * 16;
                    *(u32x4*)(O + (size_t)row * DM) = pack8u(acc[ai][0][m][0] * acc[ai][1][m][0], acc[ai][0][m][1] * acc[ai][1][m][1]); }
        } else {
            bf16_t* O = (pn < 28 ? SGA + (pn - 24) * 256 : SGC + (pn - 28) * 256) + cw;
#pragma unroll
            for (int ai = 0; ai < 2; ++ai)
#pragma unroll
                for (int m = 0; m < 4; ++m) { const int row = row0 + ai * HALF + m * 16;
#pragma unroll
                    for (int bj = 0; bj < 2; ++bj) { f32x4 v0 = acc[ai][bj][m][0], v1 = acc[ai][bj][m][1];
#pragma unroll
                        for (int e = 0; e < 4; ++e) { v0[e] = sigmoidf_(v0[e]); v1[e] = sigmoidf_(v1[e]); }
                        *(u32x4*)(O + (size_t)row * DM + bj * HALF) = pack8u(v0, v1); } }
        }
    }
};
struct EpiBranch {
    static constexpr bool PERM = true;
    const bf16_t *SGA, *SGC; float* T; bf16_t* MG;
    __device__ __forceinline__ void operator()(const f32x4 (&acc)[2][2][4][2], const Unit& u, int wr, int wc, int fr, int fq) const {
        const int type = u.pm >> 6, pm = u.pm & 63, pn = u.pn & 3;
        const int row0 = pm * BM + wr * 64 + fr, col0 = pn * BM + wc * 32 + 8 * fq;
        const bf16_t* SG = type ? SGC : SGA;
#pragma unroll
        for (int ai = 0; ai < 2; ++ai)
#pragma unroll
            for (int m = 0; m < 4; ++m) { const size_t ro = (size_t)(row0 + ai * HALF + m * 16) * DM + col0;
#pragma unroll
                for (int bj = 0; bj < 2; ++bj) { const size_t o = ro + bj * HALF;
                    f32x4 g0, g1; unpack8(*(const u32x4*)(SG + o), g0, g1);
                    f32x4 v0 = acc[ai][bj][m][0] * g0, v1 = acc[ai][bj][m][1] * g1;
                    if (type == 0) { *(f32x4*)(T + o) = v0; *(f32x4*)(T + o + 4) = v1; }
                    else { v0 = v0 + *(const f32x4*)(T + o); v1 = v1 + *(const f32x4*)(T + o + 4); *(u32x4*)(MG + o) = pack8u(v0, v1); } } }
    }
};
struct EpiH1 {
    static constexpr bool PERM = false;
    const float* X; float* H1; bf16_t* H1B; float* SSQ;
    __device__ __forceinline__ void operator()(const f32x4 (&acc)[2][2][4][2], const Unit& u, int wr, int wc, int fr, int fq) const {
        const int row0 = u.pm * BM + wr * 64 + fr, col0 = u.pn * BM + wc * 32 + 4 * fq;
#pragma unroll
        for (int ai = 0; ai < 2; ++ai)
#pragma unroll
            for (int m = 0; m < 4; ++m) { const int row = row0 + ai * HALF + m * 16; const size_t ro = (size_t)row * DM + col0; float ss = 0.f;
#pragma unroll
                for (int bj = 0; bj < 2; ++bj)
#pragma unroll
                    for (int n = 0; n < 2; ++n) { const size_t o = ro + bj * HALF + n * 16;
                        const f32x4 h = *(const f32x4*)(X + o) + acc[ai][bj][m][n];
                        *(f32x4*)(H1 + o) = h; u32x2 w; w.x = cvt_pk_bf16(h[0], h[1]); w.y = cvt_pk_bf16(h[2], h[3]); *(u32x2*)(H1B + o) = w;
                        ss += (h[0] * h[0] + h[1] * h[1]) + (h[2] * h[2] + h[3] * h[3]); }
                ss += __shfl_xor(ss, 16); ss += __shfl_xor(ss, 32);
                if (fq == 0) atomicAdd(SSQ + row, ss); }
    }
};
struct EpiSwiglu {
    static constexpr bool PERM = true;
    const float* SSQ; bf16_t* HFF;
    __device__ __forceinline__ void operator()(const f32x4 (&acc)[2][2][4][2], const Unit& u, int wr, int wc, int fr, int fq) const {
        const int row0 = u.pm * BM + wr * 64 + fr, col0 = u.pn * HALF + wc * 32 + 8 * fq;
#pragma unroll
        for (int ai = 0; ai < 2; ++ai)
#pragma unroll
            for (int m = 0; m < 4; ++m) { const int row = row0 + ai * HALF + m * 16;
                const float rstd = 1.0f / sqrtf(SSQ[row] * (1.0f / DM) + EPS);
                f32x4 o[2];
#pragma unroll
                for (int n = 0; n < 2; ++n)
#pragma unroll
                    for (int e = 0; e < 4; ++e) { const float gg = acc[ai][0][m][n][e] * rstd, uu = acc[ai][1][m][n][e] * rstd; o[n][e] = gg * sigmoidf_(gg) * uu; }
                *(u32x4*)(HFF + (size_t)row * DFF + col0) = pack8u(o[0], o[1]); }
    }
};
struct EpiDown {
    static constexpr bool PERM = false;
    float* OUT; float* SSQ;
    __device__ __forceinline__ void operator()(const f32x4 (&acc)[2][2][4][2], const Unit& u, int wr, int wc, int fr, int fq) const {
        const int row0 = u.pm * BM + wr * 64 + fr, col0 = u.pn * BM + wc * 32 + 4 * fq;
#pragma unroll
        for (int ai = 0; ai < 2; ++ai)
#pragma unroll
            for (int m = 0; m < 4; ++m) { const int row = row0 + ai * HALF + m * 16; const size_t ro = (size_t)row * DM + col0; float ss = 0.f;
#pragma unroll
                for (int bj = 0; bj < 2; ++bj)
#pragma unroll
                    for (int n = 0; n < 2; ++n) { const size_t o = ro + bj * HALF + n * 16;
                        const f32x4 h = *(const f32x4*)(OUT + o) + acc[ai][bj][m][n];
                        *(f32x4*)(OUT + o) = h;
                        ss += (h[0] * h[0] + h[1] * h[1]) + (h[2] * h[2] + h[3] * h[3]); }
                ss += __shfl_xor(ss, 16); ss += __shfl_xor(ss, 32);
                if (fq == 0) atomicAdd(SSQ + row, ss); }
    }
};
}

namespace att {
constexpr int NW = 8, QBLK = 32, KVBLK = 64, QB = NW * QBLK, D = 128, RS = DM;
constexpr int SHM_V = KVBLK * D * 2, SHM_K = KVBLK * D * 2;
constexpr int LDS_BYTES = 2 * SHM_V + 2 * SHM_K + NW * 128 * 4;
constexpr int LDS_STAGE = LDS_BYTES;
constexpr unsigned PO_STRIDE = 32u << 20, LSE_STRIDE = (unsigned)(MTOK * NHEAD * 4);
__device__ __forceinline__ unsigned po_of(unsigned po0, unsigned po2, unsigned j) { const unsigned p = po0 + j * PO_STRIDE; return j == 2u ? po2 : p; }
constexpr float THR = 8.f;
#define KSWZ(row, colB) ((row) * 256 + ((colB) ^ (((row) & 7) << 4)))
#define SBAR() __builtin_amdgcn_sched_barrier(0)
__device__ __forceinline__ int v_st(int k, int c) { const int kk = (k & ~0xC) | ((k & 4) << 1) | ((k & 8) >> 1); return ((kk >> 3) * 4 + (c >> 5)) * 512 + ((kk & 7) * 32 + (c & 31)) * 2; }
__device__ __forceinline__ int v_rd_base(int lane) { return ((lane & 3) << 3) | (((lane >> 2) & 3) << 6) | (((lane >> 4) & 1) << 5) | (((lane >> 5) & 1) << 8); }
constexpr int v_rd_off(int d0, int ks, int half) { return d0 * 512 + ks * 4096 + half * 2048; }
__device__ __forceinline__ int crow(int r, int hi) { return (r & 3) + 8 * (r >> 2) + 4 * hi; }
__device__ __forceinline__ unsigned cvtpk(float lo, float hi) { unsigned r; asm volatile("v_cvt_pk_bf16_f32 %0, %1, %2" : "=v"(r) : "v"(lo), "v"(hi)); return r; }
__device__ __forceinline__ bf16x8 load8(const bf16_t* p) { return *reinterpret_cast<const bf16x8*>(p); }
__device__ __forceinline__ void mask_causal(f32x16& p0, f32x16& p1, int dq) {
    const float NEG = -__builtin_inff();
#pragma unroll
    for (int r = 0; r < 16; ++r) { const int c = (r & 3) + 8 * (r >> 2);
        if (dq - c < 0) p0[r] = NEG;
        if (dq - c - 32 < 0) p1[r] = NEG; }
}
__device__ __forceinline__ void mask_row(f32x16& p0, f32x16& p1, bool keep) {
    const float NEG = -__builtin_inff();
#pragma unroll
    for (int r = 0; r < 16; ++r) { p0[r] = keep ? p0[r] : NEG; p1[r] = keep ? p1[r] : NEG; }
}
__device__ __forceinline__ void partialSM(f32x16& p0, f32x16& p1, float& m_reg, float& mn, float& alpha) {
    float pmax = p0[0];
#pragma unroll
    for (int r = 1; r < 16; ++r) pmax = fmaxf(pmax, p0[r]);
#pragma unroll
    for (int r = 0; r < 16; ++r) pmax = fmaxf(pmax, p1[r]);
    { auto rr = __builtin_amdgcn_permlane32_swap(__float_as_uint(pmax), __float_as_uint(pmax), false, false);
      pmax = fmaxf(__uint_as_float(rr[0]), __uint_as_float(rr[1])); }
    if (__builtin_expect(__all((pmax - m_reg) <= THR), 1)) { mn = m_reg; alpha = 1.f; }
    else { mn = fmaxf(m_reg, pmax); alpha = __builtin_amdgcn_exp2f(m_reg - mn); m_reg = mn; }
#pragma unroll
    for (int r = 0; r < 16; ++r) p0[r] = p0[r] - mn;
#pragma unroll
    for (int r = 0; r < 16; ++r) p1[r] = p1[r] - mn;
#pragma unroll
    for (int r = 0; r < 16; ++r) p0[r] = __builtin_amdgcn_exp2f(p0[r]);
}
__device__ __forceinline__ void finishSM(f32x16& p0, f32x16& p1, float alpha, float& l_reg, bf16x8& pa0, bf16x8& pa1, bf16x8& pa2, bf16x8& pa3) {
#pragma unroll
    for (int r = 0; r < 16; ++r) p1[r] = __builtin_amdgcn_exp2f(p1[r]);
    float ps = 0;
#pragma unroll
    for (int r = 0; r < 16; ++r) ps += p0[r];
#pragma unroll
    for (int r = 0; r < 16; ++r) ps += p1[r];
    { auto rr = __builtin_amdgcn_permlane32_swap(__float_as_uint(ps), __float_as_uint(ps), false, false);
      ps = __uint_as_float(rr[0]) + __uint_as_float(rr[1]); }
    l_reg = l_reg * alpha + ps;
#define PK4(P, B_, OUT) do { unsigned a0 = cvtpk(P[B_+0], P[B_+1]), a1 = cvtpk(P[B_+2], P[B_+3]);                          \
        unsigned b0 = cvtpk(P[B_+4], P[B_+5]), b1 = cvtpk(P[B_+6], P[B_+7]);                                             \
        auto r0 = __builtin_amdgcn_permlane32_swap(a0, b0, false, false); auto r1 = __builtin_amdgcn_permlane32_swap(a1, b1, false, false); \
        u32x4 w = {r0[0], r1[0], r0[1], r1[1]}; OUT = *reinterpret_cast<bf16x8*>(&w); } while (0)
    PK4(p0, 0, pa0); PK4(p0, 8, pa1); PK4(p1, 0, pa2); PK4(p1, 8, pa3);
#undef PK4
}
template <int KB>
__device__ __forceinline__ void qkt(f32x16& p0, f32x16& p1, const char* K_lds, int r32, int hi, const bf16x8* qr, bool act) {
    if (!act) { const float NEG = -__builtin_inff();
#pragma unroll
        for (int r = 0; r < 16; ++r) { p0[r] = NEG; p1[r] = NEG; } return; }
    p0 = f32x16{}; p1 = f32x16{};
    const char* kb[4];
#pragma unroll
    for (int dd = 0; dd < 4; ++dd) kb[dd] = K_lds + KB * SHM_K + KSWZ(r32, (dd * 16 + hi * 8) * 2);
#pragma unroll
    for (int d0 = 0; d0 < 8; ++d0) { const char* a = kb[d0 & 3] + (d0 >> 2) * 128;
        bf16x8 b0 = *reinterpret_cast<const bf16x8*>(a);
        bf16x8 b1 = *reinterpret_cast<const bf16x8*>(a + 32 * 256);
        p0 = __builtin_amdgcn_mfma_f32_32x32x16_bf16(b0, qr[d0], p0, 0, 0, 0);
        p1 = __builtin_amdgcn_mfma_f32_32x32x16_bf16(b1, qr[d0], p1, 0, 0, 0); }
}
template <int VB>
__device__ __forceinline__ void pv_tile(f32x16* o, int vb0, bf16x8 pa0, bf16x8 pa1, bf16x8 pa2, bf16x8 pa3, bool act) {
    if (!act) return;
#define TRRD(dst, off) asm volatile("ds_read_b64_tr_b16 %0, %1 offset:%2" : "=&v"(dst) : "v"(vb0), "i"(off) : "memory")
#define PV_D0(d0) do { s16x4 l0, l1, l2, l3, h0, h1, h2, h3; constexpr int b_ = VB * SHM_V + v_rd_off(d0, 0, 0); \
        TRRD(l0, b_); TRRD(h0, b_ + 2048); TRRD(l1, b_ + 4096); TRRD(h1, b_ + 6144); TRRD(l2, b_ + 8192); TRRD(h2, b_ + 10240); TRRD(l3, b_ + 12288); TRRD(h3, b_ + 14336); \
        asm volatile("s_waitcnt lgkmcnt(0)" ::: "memory"); SBAR();   \
        o[d0] = __builtin_amdgcn_mfma_f32_32x32x16_bf16(pa0, (bf16x8){l0[0], l0[1], l0[2], l0[3], h0[0], h0[1], h0[2], h0[3]}, o[d0], 0, 0, 0);   \
        o[d0] = __builtin_amdgcn_mfma_f32_32x32x16_bf16(pa1, (bf16x8){l1[0], l1[1], l1[2], l1[3], h1[0], h1[1], h1[2], h1[3]}, o[d0], 0, 0, 0);   \
        o[d0] = __builtin_amdgcn_mfma_f32_32x32x16_bf16(pa2, (bf16x8){l2[0], l2[1], l2[2], l2[3], h2[0], h2[1], h2[2], h2[3]}, o[d0], 0, 0, 0);   \
        o[d0] = __builtin_amdgcn_mfma_f32_32x32x16_bf16(pa3, (bf16x8){l3[0], l3[1], l3[2], l3[3], h3[0], h3[1], h3[2], h3[3]}, o[d0], 0, 0, 0); } while (0)
    PV_D0(0); PV_D0(1); PV_D0(2); PV_D0(3);
#undef PV_D0
#undef TRRD
}
struct BlockRef { const bf16_t* Qb; const bf16_t* K; const bf16_t* V; const unsigned short* list; int nrows; int qb; unsigned po0, po2, lo0; bf16_t* O; };
struct Seam { bf16x8 qr[8]; bf16x8 st_v0, st_v1, st_k0, st_k1; int ent; };
#define LD16(base, off) (*reinterpret_cast<const bf16x8*>((const char*)(base) + (off)))
#define VMW() asm volatile("s_waitcnt vmcnt(0)" ::: "memory")
#define VMWN(n) asm volatile("s_waitcnt vmcnt(%0)" :: "i"(n) : "memory")
#define SLOAD_H(Kp, Vp, k0) do { const char* kb_ = (const char*)(Kp) + (size_t)(k0) * (RS * 2); const char* vb_ = (const char*)(Vp) + (size_t)(k0) * (RS * 2); \
                         S.st_v0 = LD16(vb_, lofs); S.st_v1 = LD16(vb_ + 32 * RS * 2, lofs);              \
                         S.st_k0 = LD16(kb_, lofs); S.st_k1 = LD16(kb_ + 32 * RS * 2, lofs); } while (0)
#define SWRITE_HK(bf) do { *(bf16x8*)(K_lds + (bf) * SHM_K + kws) = S.st_k0; *(bf16x8*)(K_lds + (bf) * SHM_K + kws + 32 * 256) = S.st_k1; } while (0)
#define SWRITE_HV(bf) do { *(bf16x8*)(V_lds + (bf) * SHM_V + vst0) = S.st_v0; *(bf16x8*)(V_lds + (bf) * SHM_V + vst1) = S.st_v1; } while (0)
#define SWRITE_H(bf) do { SWRITE_HV(bf); SWRITE_HK(bf); } while (0)
__host__ __device__ __forceinline__ int list_off(int n) { return 256 * (31 * n - (n * (n - 1)) / 2); }

__device__ __forceinline__ void gate_lists(const bf16_t* Qb, const float* KM, int qb, unsigned* CNT, unsigned short* LISTbh) {
    int tid = threadIdx.x; asm volatile("" : "+v"(tid));
    const int wid = __builtin_amdgcn_readfirstlane(tid >> 6), lane = tid & 63, r32 = lane & 31, hi = lane >> 5;
    if (qb == 0) return;
    const int srow = qb * QB + wid * QBLK + r32;
    bf16x8 qr[8];
    { const unsigned qofs = (unsigned)(srow * RS + hi * 8) * 2u;
#pragma unroll
      for (int d0 = 0; d0 < 8; ++d0) qr[d0] = LD16((const char*)Qb + d0 * 32, qofs); }
    unsigned sel = 0u;
    {
        f32x16 g = f32x16{};
#pragma unroll
        for (int d0 = 0; d0 < 8; ++d0) {
            const char* kp = (const char*)KM + d0 * 64; const unsigned kofs = (unsigned)(r32 * D + hi * 8) * 4u;
            const f32x4 a = *(const f32x4*)(kp + kofs), b = *(const f32x4*)(kp + 16 + kofs);
            const u32x4 wh = pack8u(a, b); f32x4 ah, bh; unpack8(wh, ah, bh);
            const u32x4 wl = pack8u(a - ah, b - bh);
            g = __builtin_amdgcn_mfma_f32_32x32x16_bf16(*reinterpret_cast<const bf16x8*>(&wh), qr[d0], g, 0, 0, 0);
            g = __builtin_amdgcn_mfma_f32_32x32x16_bf16(*reinterpret_cast<const bf16x8*>(&wl), qr[d0], g, 0, 0, 0);
        }
        const float NEG = -__builtin_inff();
#pragma unroll
        for (int r = 0; r < 16; ++r) if (crow(r, hi) >= qb) g[r] = NEG;
#pragma unroll
        for (int round = 0; round < 3; ++round) {
            float bv = NEG; int bn = 64;
#pragma unroll
            for (int r = 0; r < 16; ++r) if (g[r] > bv) { bv = g[r]; bn = crow(r, hi); }
            const float ov = __shfl_xor(bv, 32); const int on = __shfl_xor(bn, 32);
            if (ov > bv || (ov == bv && on < bn)) { bv = ov; bn = on; }
            if (bv > NEG) sel |= 1u << bn;
#pragma unroll
            for (int r = 0; r < 16; ++r) if (crow(r, hi) == bn) g[r] = NEG;
        }
    }
    const bool lo = hi == 0;
    unsigned mycnt = 0u;
    for (int n = 0; n < qb; ++n) { const unsigned long long m = __ballot(lo && ((sel >> n) & 1u)); if (lane == n) mycnt = (unsigned)__popcll(m); }
    unsigned mybase = 0u;
    if (lane < qb && mycnt) mybase = atomicAdd(CNT + lane, mycnt);
    for (int n = 0; n < qb; ++n) {
        const bool bit = lo && ((sel >> n) & 1u); const unsigned long long m = __ballot(bit);
        const unsigned base = __shfl(mybase, n);
        if (bit) { const unsigned rank = (unsigned)__popcll(m & ((1ull << lane) - 1ull)), j = (unsigned)__popc(sel & ((1u << n) - 1u));
            LISTbh[list_off(n) + base + rank] = (unsigned short)((unsigned)srow | (j << 13)); }
    }
}

template <int MODE>
__device__ __forceinline__ void attn_prime(const BlockRef& cur, char* lds, Seam& S) {
    int tid = threadIdx.x; asm volatile("" : "+v"(tid));
    const int wid = __builtin_amdgcn_readfirstlane(tid >> 6), lane = tid & 63, r32 = lane & 31, hi = lane >> 5;
    const int sr = tid >> 4, sc = (tid & 15) * 8, kws = KSWZ(sr, sc * 2); char* K_lds = lds + 2 * SHM_V;
    const unsigned lofs = (unsigned)(sr * RS + sc) * 2u;
    int srow;
    if (MODE == 0) { int idx = wid * QBLK + r32; idx = idx < cur.nrows ? idx : cur.nrows - 1; S.ent = cur.list[idx]; srow = S.ent & 0x1fff; }
    else { S.ent = 0; srow = cur.qb * QB + wid * QBLK + r32; }
    { const unsigned qofs = (unsigned)(srow * RS + hi * 8) * 2u;
#pragma unroll
      for (int d0 = 0; d0 < 8; ++d0) S.qr[d0] = LD16((const char*)cur.Qb + d0 * 32, qofs); }
    SLOAD_H(cur.K, cur.V, 0); VMW(); SWRITE_HK(0);
    __syncthreads();
}
template <int MODE>
__device__ __forceinline__ void attn_block(const BlockRef& cur, const BlockRef& nxt, char* lds, Seam& S, unsigned char* wsb) {
    int tid = threadIdx.x; asm volatile("" : "+v"(tid));
    const int wid = __builtin_amdgcn_readfirstlane(tid >> 6), lane = tid & 63, r32 = lane & 31, hi = lane >> 5;
    constexpr int NT = 4;
    const int qrel = wid * QBLK;
    const bool wact = MODE == 0 ? (qrel < cur.nrows) : true;
    char* V_lds = lds; char* K_lds = lds + 2 * SHM_V;
    float* ws = (float*)(lds + 2 * SHM_V + 2 * SHM_K) + wid * 128; float* li_l = ws, * al_l = ws + 32, * t2_l = ws + 64, * t3_l = ws + 96;
    int ent_nx = 0;
    if (MODE == 0) { int idx = qrel + r32; idx = idx < nxt.nrows ? idx : nxt.nrows - 1; ent_nx = nxt.list[idx]; }
    float m_reg = -1e30f, l_reg = 0; f32x16 o[4] = {};
    const int sr = tid >> 4, sc = (tid & 15) * 8, vst0 = v_st(sr, sc), vst1 = v_st(32 + sr, sc), kws = KSWZ(sr, sc * 2);
    const unsigned lofs = (unsigned)(sr * RS + sc) * 2u;
    const int vb0 = (int)(uintptr_t)V_lds + v_rd_base(lane);
    const bf16_t* Kh = cur.K; const bf16_t* Vh = cur.V;
#define RESC(a) do { if (__any((a) < 1.f)) { if (hi == 0) al_l[r32] = (a); asm volatile("s_waitcnt lgkmcnt(0)" ::: "memory");              \
                     for (int d_ = 0; d_ < 4; ++d_) for (int r = 0; r < 16; ++r) o[d_][r] *= al_l[crow(r, hi)]; } } while (0)
#define KBASE(t) ((t) * KVBLK)
#define ACT(t) (MODE == 0 ? wact : (((t) * KVBLK) <= qrel + QBLK - 1))
#define MASKT(P0_, P1_, t) do { if (MODE == 1) { const int kbl_ = (t) * KVBLK; if (kbl_ + KVBLK - 1 > qrel) mask_causal(P0_, P1_, qrel + r32 - 4 * hi - kbl_); } } while (0)
    constexpr int NQL = 8;
#define SEAM_K0() do { VMWN(NQL); SWRITE_HK(0); SBAR(); } while (0)
    f32x16 pA0, pA1, pB0, pB1; float mnA, mnB, alA, alB; bf16x8 pa0, pa1, pa2, pa3;
    SWRITE_HV(0); SBAR();
    SLOAD_H(Kh, Vh, KBASE(1));
    SBAR(); qkt<0>(pA0, pA1, K_lds, r32, hi, S.qr, ACT(0));
    MASKT(pA0, pA1, 0); partialSM(pA0, pA1, m_reg, mnA, alA);
    VMW(); SWRITE_H(1);
    __syncthreads();
#define HALF_STEP(PX0, PX1, mnX, alX, PY0, PY1, alY, t, KB, VB, SB) do {                                                      \
        SBAR(); qkt<KB>(PX0, PX1, K_lds, r32, hi, S.qr, ACT(t));                                             \
        finishSM(PY0, PY1, alY, l_reg, pa0, pa1, pa2, pa3); SBAR();                                                           \
        if ((t) + 1 < NT) { SLOAD_H(Kh, Vh, KBASE((t) + 1)); SBAR(); }                                               \
        pv_tile<VB>(o, vb0, pa0, pa1, pa2, pa3, ACT((t) - 1)); MASKT(PX0, PX1, (t)); partialSM(PX0, PX1, m_reg, mnX, alX);                                        \
        __syncthreads();                                                                                                      \
        if ((t) + 1 < NT) { VMW(); SWRITE_H(SB); }                                                                          \
        RESC(alX); __syncthreads(); } while (0)
    HALF_STEP(pB0, pB1, mnB, alB, pA0, pA1, alA, 1, 1, 0, 0);
    HALF_STEP(pA0, pA1, mnA, alA, pB0, pB1, alB, 2, 0, 1, 1);
    SBAR(); qkt<1>(pB0, pB1, K_lds, r32, hi, S.qr, ACT(NT - 1)); SBAR();
    SLOAD_H(nxt.K, nxt.V, 0); SBAR();
    { const int srown = MODE == 0 ? (ent_nx & 0x1fff) : (nxt.qb * QB + wid * QBLK + r32); const unsigned qofs = (unsigned)(srown * RS + hi * 8) * 2u;
#pragma unroll
    for (int d0 = 0; d0 < 8; ++d0) S.qr[d0] = LD16((const char*)nxt.Qb + d0 * 32, qofs); }
    SBAR();
    finishSM(pA0, pA1, alA, l_reg, pa0, pa1, pa2, pa3); SBAR();
    pv_tile<0>(o, vb0, pa0, pa1, pa2, pa3, ACT(NT - 2));
    MASKT(pB0, pB1, NT - 1); partialSM(pB0, pB1, m_reg, mnB, alB); __syncthreads(); RESC(alB);
    finishSM(pB0, pB1, alB, l_reg, pa0, pa1, pa2, pa3); SBAR(); pv_tile<1>(o, vb0, pa0, pa1, pa2, pa3, ACT(NT - 1));
    SBAR(); SEAM_K0();
    if (MODE == 0) {
        const int ent = S.ent;
        if (hi == 0) { li_l[r32] = l_reg; ((int*)al_l)[r32] = ent; } asm volatile("s_waitcnt lgkmcnt(0)" ::: "memory");
        if (hi == 0 && qrel + r32 < cur.nrows) { const unsigned j = (unsigned)ent >> 13; const unsigned lofsj = cur.lo0 + j * LSE_STRIDE + (unsigned)(ent & 0x1fff) * 4u;
            *(float*)(wsb + lofsj) = m_reg + __builtin_amdgcn_logf(l_reg); }
#pragma unroll
        for (int r = 0; r < 16; ++r) { const int rw = crow(r, hi); const float rl = __builtin_amdgcn_rcpf(li_l[rw]); const int e = ((const int*)al_l)[rw];
            const bool valid = qrel + rw < cur.nrows; const unsigned j = (unsigned)e >> 13;
            const unsigned ob = po_of(cur.po0, cur.po2, j) + (unsigned)((e & 0x1fff) * RS + r32) * 2u;
#pragma unroll
            for (int d0 = 0; d0 < 4; ++d0) { const float v = o[d0][r] * rl; const float vn = __shfl_xor(v, 1);
                if ((r32 & 1) == 0 && valid) *(unsigned*)(wsb + ob + d0 * 64) = cvtpk(v, vn); } }
    } else {
        const int nprev = cur.qb < 3 ? cur.qb : 3;
        const int srow = cur.qb * QB + qrel + r32;
        {   const float NEG = -__builtin_inff();
            float l0 = NEG, l1 = NEG, l2 = NEG;
            if (nprev > 0) l0 = *(const float*)(wsb + cur.lo0 + (unsigned)srow * 4u);
            if (nprev > 1) l1 = *(const float*)(wsb + cur.lo0 + LSE_STRIDE + (unsigned)srow * 4u);
            if (nprev > 2) l2 = *(const float*)(wsb + cur.lo0 + 2u * LSE_STRIDE + (unsigned)srow * 4u);
            const float M = fmaxf(fmaxf(m_reg, l0), fmaxf(l1, l2));
            const float wo = __builtin_amdgcn_exp2f(m_reg - M), w0 = __builtin_amdgcn_exp2f(l0 - M), w1 = __builtin_amdgcn_exp2f(l1 - M), w2 = __builtin_amdgcn_exp2f(l2 - M);
            const float rL = 1.0f / (l_reg * wo + w0 + w1 + w2);
            if (hi == 0) { li_l[r32] = wo * rL; al_l[r32] = w0 * rL; t2_l[r32] = w1 * rL; t3_l[r32] = w2 * rL; }
            asm volatile("s_waitcnt lgkmcnt(0)" ::: "memory");
        }
#pragma unroll
        for (int r = 0; r < 16; ++r) { const float w = li_l[crow(r, hi)];
#pragma unroll
            for (int d0 = 0; d0 < 4; ++d0) o[d0][r] *= w; }
        char* stg = lds + LDS_STAGE + wid * (32 * 272);
        for (int j = 0; j < nprev; ++j) {
            const unsigned pb = po_of(cur.po0, cur.po2, (unsigned)j) + (unsigned)((cur.qb * QB + qrel) * RS) * 2u;
            const float* wt = j == 0 ? al_l : j == 1 ? t2_l : t3_l;
#pragma unroll
            for (int i = 0; i < 8; ++i) { const int ch = i * 64 + lane, row = ch >> 4, c16 = ch & 15;
                const u32x4 v = *(const u32x4*)(wsb + pb + (unsigned)(row * RS + c16 * 8) * 2u); *(u32x4*)(stg + row * 272 + c16 * 16) = v; }
            asm volatile("s_waitcnt lgkmcnt(0)" ::: "memory");
#pragma unroll
            for (int r = 0; r < 16; ++r) { const int rw = crow(r, hi); const float w = wt[rw];
#pragma unroll
                for (int d0 = 0; d0 < 4; ++d0) { const unsigned short hv = *(const unsigned short*)(stg + rw * 272 + (d0 * 32 + r32) * 2);
                    o[d0][r] += w * __uint_as_float((unsigned)hv << 16); } }
            asm volatile("s_waitcnt lgkmcnt(0)" ::: "memory");
        }
        char* Ow = (char*)cur.O + (size_t)(cur.qb * QB + qrel) * (RS * 2);
        const unsigned oofs = (unsigned)((4 * hi) * RS + r32) * 2u;
#pragma unroll
        for (int r = 0; r < 16; ++r) { const int orow = (r & 3) + 8 * (r >> 2);
#pragma unroll
            for (int d0 = 0; d0 < 4; ++d0) { const float v = o[d0][r]; const float vn = __shfl_xor(v, 1);
                if ((r32 & 1) == 0) *(unsigned*)(Ow + (orow * RS + d0 * 32) * 2 + oofs) = cvtpk(v, vn); } }
    }
    S.ent = ent_nx;
    __syncthreads();
#undef RESC
#undef KBASE
#undef ACT
#undef MASKT
#undef SEAM_K0
#undef HALF_STEP
}
#undef LD16
#undef VMW
#undef VMWN
#undef SLOAD_H
#undef SWRITE_HK
#undef SWRITE_HV
#undef SWRITE_H
#undef KSWZ
#undef SBAR
}

constexpr size_t MiB = 1u << 20;
constexpr size_t WS_CTL = 0, CTL_ZERO_BYTES = 1 * MiB;
constexpr size_t WS_BAR = 16384;
constexpr size_t WS_CNT = 128 * 1024;
constexpr size_t WS_SSQ1 = 256 * 1024, WS_SSQ2 = 320 * 1024, WS_KM = 512 * 1024;
constexpr size_t WS_WIN = 1 * MiB;
constexpr size_t WS_WAC = 17 * MiB;
constexpr size_t WS_WOUT = 21 * MiB;
constexpr size_t WS_WGU = 23 * MiB;
constexpr size_t WS_WDN = 34 * MiB;
constexpr size_t WS_ROPE = 40 * MiB;
constexpr size_t WS_U = 42 * MiB;
constexpr size_t WS_V = 74 * MiB, WS_P = 106 * MiB, WS_BG = 138 * MiB, WS_SGA = 170 * MiB, WS_SGC = 202 * MiB;
constexpr size_t WS_T = 74 * MiB;
constexpr size_t WS_MG = 138 * MiB;
constexpr size_t WS_H1B = 170 * MiB;
constexpr size_t WS_HFF = 42 * MiB;
constexpr size_t WS_PO0 = 106 * MiB, WS_PO1 = 138 * MiB;
constexpr size_t WS_PO2A = 1 * MiB;
constexpr size_t WS_PO2B = 234 * MiB;
constexpr size_t WS_LSE = 250 * MiB;
constexpr size_t WS_LIST = 252 * MiB;
constexpr int LIST_PER_BH = 256 * 496;
constexpr size_t WS_END = 256 * MiB;
constexpr int LDS_BYTES = 147456;
constexpr int NTHREADS = 512;
constexpr int LDS_MISC = LDS_BYTES - 256;


#define XB_TMO      128
#define XB_XCNT(j)  (256  + 64 * (j))
#define XB_XSUB(j)  (1280 + 64 * (j))
#define XB_XGEN(j)  (2304 + 64 * (j))
#define XB_TOP      3328
#define XB_TOPGEN   3392
#define XCD_BAR_WORDS 3456
#define XB_SPIN_CAP (1u << 18)
__device__ __forceinline__ unsigned xb_ld(unsigned* p)              { return __hip_atomic_load(p, __ATOMIC_RELAXED, __HIP_MEMORY_SCOPE_AGENT); }
__device__ __forceinline__ unsigned xb_add(unsigned* p, unsigned v) { return __hip_atomic_fetch_add(p, v, __ATOMIC_RELAXED, __HIP_MEMORY_SCOPE_AGENT); }
__device__ __forceinline__ unsigned xb_xcc_id() { return (unsigned)__builtin_amdgcn_s_getreg((3 << 11) | 20) & 0xFu; }
#define XB_SPIN(cond, bar) do { unsigned _sp = 0; while (cond) { __builtin_amdgcn_s_sleep(1); \
    if ((++_sp & 255u) == 0u) { if (xb_ld(&(bar)[XB_TMO])) break; if (_sp > XB_SPIN_CAP) { atomicAdd(&(bar)[XB_TMO], 1u); break; } } } } while (0)
struct XcdBarrier { unsigned* bar; unsigned x; volatile LAS unsigned* st; };
__device__ __forceinline__ XcdBarrier xcd_barrier_post(unsigned* bar, volatile LAS unsigned* st) {
    XcdBarrier b; b.bar = bar; b.x = xb_xcc_id(); b.st = st;
    if (threadIdx.x == 0) (void)xb_add(&bar[XB_XCNT(b.x)], 1u);
    return b;
}
__device__ __forceinline__ void xcd_barrier_complete(unsigned* bar, unsigned x, unsigned& nloc, unsigned& nx) {
    const unsigned G = gridDim.x * gridDim.y * gridDim.z;
    unsigned sum, cnt, mine, sp = 0u;
    for (;;) {
        sum = 0u; cnt = 0u; mine = 0u;
#pragma unroll
        for (unsigned j = 0; j < 16; ++j) { const unsigned c = xb_ld(&bar[XB_XCNT(j)]); sum += c; cnt += (c > 0u) ? 1u : 0u; mine = (j == x) ? c : mine; }
        if (sum == G) break;
        __builtin_amdgcn_s_sleep(1);
        if ((++sp & 255u) == 0u) { if (xb_ld(&bar[XB_TMO])) break; if (sp > XB_SPIN_CAP) { atomicAdd(&bar[XB_TMO], 1u); break; } }
    }
    nloc = mine > 0u ? mine : 1u; nx = cnt > 0u ? cnt : 1u;
}
__device__ __forceinline__ void xcd_barrier(const XcdBarrier& b) {
    asm volatile("s_waitcnt vmcnt(0)" ::: "memory");
    __syncthreads();
    if (threadIdx.x == 0) {
        unsigned* bar = b.bar;
        __builtin_amdgcn_s_waitcnt(0);
        unsigned nloc = b.st[0], nx = b.st[1];
        if (nloc == 0u) { xcd_barrier_complete(bar, b.x, nloc, nx); b.st[0] = nloc; b.st[1] = nx; }
        const unsigned old = xb_add(&bar[XB_XSUB(b.x)], 1u);
        const unsigned gen = old / nloc;
        if (old + 1u == (gen + 1u) * nloc) {
            __builtin_amdgcn_fence(__ATOMIC_RELEASE, "agent");
            asm volatile("s_waitcnt vmcnt(0)" ::: "memory");
            const unsigned og = xb_add(&bar[XB_TOP], 1u);
            const unsigned tg = og / nx;
            if (og + 1u == (tg + 1u) * nx) xb_add(&bar[XB_TOPGEN], 1u);
            else XB_SPIN(xb_ld(&bar[XB_TOPGEN]) == tg, bar);
            __builtin_amdgcn_fence(__ATOMIC_ACQUIRE, "agent");
            xb_add(&bar[XB_XGEN(b.x)], 1u);
            asm volatile("s_waitcnt vmcnt(0)" ::: "memory");
        } else {
            XB_SPIN(xb_ld(&bar[XB_XGEN(b.x)]) == gen, bar);
            __builtin_amdgcn_fence(__ATOMIC_ACQUIRE, "agent");
            asm volatile("s_waitcnt vmcnt(0)" ::: "memory");
        }
    }
    __syncthreads();
}

struct Args { const float* in[11]; float* out; unsigned char* ws; int use_cg; int pad; };

__device__ __forceinline__ size_t opq0() { size_t z = 0; asm volatile("" : "+s"(z)); return z; }
__device__ __forceinline__ float wave_sum(float v) {
#pragma unroll
    for (int o = 1; o < 64; o <<= 1) v += __shfl_xor(v, o);
    return v;
}
__device__ __forceinline__ void transpose_item(const float* W, int N, bf16_t* WT, int Kld, int k0, int n0, int dst_row0, const float* kscale, LAS float* scr, int lane) {
    const int kr = lane >> 3, nq = lane & 7;
    f32x4 v[8];
#pragma unroll
    for (int i = 0; i < 8; ++i) v[i] = *(const f32x4*)(W + (size_t)(k0 + 8 * i + kr) * N + n0 + 4 * nq);
#pragma unroll
    for (int i = 0; i < 8; ++i) { const int kk = 8 * i + kr; f32x4 x = v[i]; if (kscale) x = x * kscale[k0 + kk];
        LAS float* d = scr + kk * 33 + 4 * nq; d[0] = x[0]; d[1] = x[1]; d[2] = x[2]; d[3] = x[3]; }
    asm volatile("s_waitcnt lgkmcnt(0)" ::: "memory");
    const int c = lane & 7;
#pragma unroll
    for (int j = 0; j < 4; ++j) { const int n = (lane >> 3) + 8 * j; const LAS float* s = scr + (8 * c) * 33 + n;
        u32x4 o; o.x = cvt_pk_bf16(s[0 * 33], s[1 * 33]); o.y = cvt_pk_bf16(s[2 * 33], s[3 * 33]); o.z = cvt_pk_bf16(s[4 * 33], s[5 * 33]); o.w = cvt_pk_bf16(s[6 * 33], s[7 * 33]);
        *(u32x4*)(WT + (size_t)(dst_row0 + n) * Kld + k0 + 8 * c) = o; }
    asm volatile("s_waitcnt lgkmcnt(0)" ::: "memory");
}
__device__ __forceinline__ int map_in(int n0) {
    if (n0 < 3072) return n0;
    if (n0 < 4096) { const int j = n0 - 3072; return 256 * (12 + (j >> 7)) + (j & 127); }
    if (n0 < 5120) return 5120 + (n0 - 4096);
    if (n0 < 6144) { const int j = n0 - 5120; return 256 * (12 + (j >> 7)) + 128 + (j & 127); }
    return n0;
}
__device__ __forceinline__ int map_gu(int n0) { const int j = n0 < DFF ? n0 : n0 - DFF; return 256 * (j >> 7) + (n0 < DFF ? 0 : 128) + (j & 127); }


#ifndef DBG_ATTN
#define DBG_ATTN 0
#endif
#if DBG_ATTN
__device__ __forceinline__ void dbg_check(const bf16_t* QC, const bf16_t* Kg, const bf16_t* Vg, const bf16_t* ATTN, const float* KM, unsigned* dbgmax, LAS unsigned char* lds, int gw, int NGW, int lane, int wave) {
    LAS float* qs = (LAS float*)(lds + wave * 8192);
    LAS float* sc = qs + 128;
    const float NEG = -__builtin_inff();
    for (int task = gw; task * 5 < MTOK * NHEAD; task += NGW) {
        const int flat = task * 5, b = flat >> 16, s = (flat >> 3) & (SEQ - 1), h = flat & 7, blk = s >> 8;
        const size_t rowoff = ((size_t)b * SEQ + s) * DM + h * HD;
        { const unsigned w = *(const unsigned*)(QC + rowoff + 2 * lane); qs[2 * lane] = bf_lo(w); qs[2 * lane + 1] = bf_hi(w); }
        asm volatile("s_waitcnt lgkmcnt(0)" ::: "memory");
        float g = NEG;
        if (lane < blk) { const float* km = KM + ((size_t)(b * NHEAD + h) * NKB + lane) * HD; float a = 0.f; for (int d = 0; d < HD; ++d) a += qs[d] * km[d]; g = a; }
        int sb0 = -1, sb1 = -1, sb2 = -1;
#pragma unroll
        for (int round = 0; round < 3; ++round) {
            float bv = g; int bi = lane;
#pragma unroll
            for (int o = 32; o >= 1; o >>= 1) { const float ov = __shfl_xor(bv, o); const int oi = __shfl_xor(bi, o); if (ov > bv || (ov == bv && oi < bi)) { bv = ov; bi = oi; } }
            if (bv > NEG) { if (round == 0) sb0 = bi; else if (round == 1) sb1 = bi; else sb2 = bi; if (lane == bi) g = NEG; }
        }
        float mloc = NEG;
#pragma unroll
        for (int slot = 0; slot < 4; ++slot) {
            const int n = slot == 0 ? sb0 : slot == 1 ? sb1 : slot == 2 ? sb2 : blk;
            for (int kk = 0; kk < 4; ++kk) { const int key = kk * 64 + lane; float sv = NEG;
                if (n >= 0) { const bf16_t* kr = Kg + ((size_t)b * SEQ + n * 256 + key) * DM + h * HD; float a = 0.f;
                    for (int c = 0; c < 16; ++c) { f32x4 x0, x1; unpack8(*(const u32x4*)(kr + 8 * c), x0, x1);
                        a += x0[0] * qs[8 * c] + x0[1] * qs[8 * c + 1] + x0[2] * qs[8 * c + 2] + x0[3] * qs[8 * c + 3] + x1[0] * qs[8 * c + 4] + x1[1] * qs[8 * c + 5] + x1[2] * qs[8 * c + 6] + x1[3] * qs[8 * c + 7]; }
                    sv = a; if (slot == 3 && key > (s & 255)) sv = NEG; }
                sc[slot * 256 + key] = sv; mloc = fmaxf(mloc, sv); }
        }
#pragma unroll
        for (int o = 32; o >= 1; o >>= 1) mloc = fmaxf(mloc, __shfl_xor(mloc, o));
        asm volatile("s_waitcnt lgkmcnt(0)" ::: "memory");
        float lsum = 0.f;
        for (int i = lane; i < 1024; i += 64) { const float p = exp2f(sc[i] - mloc); sc[i] = p; lsum += p; }
        lsum = wave_sum(lsum);
        asm volatile("s_waitcnt lgkmcnt(0)" ::: "memory");
        float a0 = 0.f, a1 = 0.f;
#pragma unroll
        for (int slot = 0; slot < 4; ++slot) {
            const int n = slot == 0 ? sb0 : slot == 1 ? sb1 : slot == 2 ? sb2 : blk;
            if (n < 0) continue;
            const bf16_t* vr = Vg + ((size_t)b * SEQ + n * 256) * DM + h * HD + 2 * lane;
            for (int key = 0; key < 256; ++key) { const float p = sc[slot * 256 + key]; const unsigned v = *(const unsigned*)(vr + (size_t)key * DM); a0 += p * bf_lo(v); a1 += p * bf_hi(v); }
        }
        const float o0 = a0 / lsum, o1 = a1 / lsum;
        const unsigned w = *(const unsigned*)(ATTN + rowoff + 2 * lane);
        float err = fmaxf(fabsf(o0 - bf_lo(w)), fabsf(o1 - bf_hi(w)));
        if (!(err == err)) err = 1e6f;
#pragma unroll
        for (int o = 32; o >= 1; o >>= 1) err = fmaxf(err, __shfl_xor(err, o));
        if (lane == 0) atomicMax(dbgmax, __float_as_uint(err));
        asm volatile("s_waitcnt lgkmcnt(0)" ::: "memory");
    }
}
#endif

__global__ void __launch_bounds__(NTHREADS, 2) mk_fwd(Args args) {
    extern __shared__ __attribute__((aligned(16))) unsigned char lds[];
    cg::grid_group grid = cg::this_grid();
    { volatile LAS unsigned* st0 = (volatile LAS unsigned*)((LAS unsigned char*)lds + LDS_MISC); if (threadIdx.x < 2) st0[threadIdx.x] = 0u; __syncthreads(); }
    const XcdBarrier xbar = xcd_barrier_post((unsigned*)(args.ws + WS_BAR), (volatile LAS unsigned*)((LAS unsigned char*)lds + LDS_MISC));
    if (args.use_cg) grid.sync();
#define GRID_BAR() xcd_barrier(xbar)
#ifndef PROBE_PHASE
#define PROBE_PHASE -1
#endif
#define PH_BEGIN(k) unsigned long long t0_ = 0; if (PROBE_PHASE == (k)) t0_ = __builtin_amdgcn_s_memrealtime()
#define PH_END(k) do { if (PROBE_PHASE == (k)) { const unsigned long long t1_ = __builtin_amdgcn_s_memrealtime(); while (__builtin_amdgcn_s_memrealtime() - t1_ < 2 * (t1_ - t0_)) __builtin_amdgcn_s_sleep(8); } } while (0)
    const int G = gridDim.x, bx = blockIdx.x;
#define TIDS() int tid = threadIdx.x; asm volatile("" : "+v"(tid)); const int lane = tid & 63, wave = __builtin_amdgcn_readfirstlane(tid >> 6); (void)lane; (void)wave
    const int vcu = (G % 8 == 0) ? (bx % 8) * (G / 8) + bx / 8 : bx;
#define OPQ(p) ((p) + opq0())
#define WSP(T, off) ((T*)(ws + (off)))
    LAS unsigned char* ldsl = (LAS unsigned char*)lds;

    {
        PH_BEGIN(0);
        TIDS();
        unsigned char* ws = OPQ(args.ws);
        const float* x = OPQ(args.in[0]); const float* g_mix = OPQ(args.in[1]); const float* w_in = OPQ(args.in[2]); const float* w_a = OPQ(args.in[4]); const float* w_c = OPQ(args.in[5]);
        const float* w_out = OPQ(args.in[6]); const float* g_ffn = OPQ(args.in[7]); const float* w_gu = OPQ(args.in[8]); const float* w_dn = OPQ(args.in[9]);
        bf16_t* WIN = WSP(bf16_t, WS_WIN); bf16_t* WAC = WSP(bf16_t, WS_WAC); bf16_t* WOUT = WSP(bf16_t, WS_WOUT); bf16_t* WGU = WSP(bf16_t, WS_WGU); bf16_t* WDN = WSP(bf16_t, WS_WDN);
        float* ROPEC = WSP(float, WS_ROPE); float* ROPES = ROPEC + SEQ * 16; bf16_t* U = WSP(bf16_t, WS_U);
        LAS float* scr = (LAS float*)(ldsl + wave * 16384);
        const int gw = vcu * 8 + wave, NGW = G * 8;
        constexpr int I_IN = 16 * 256, I_SQ = 16 * 32, I_GU = 16 * 176, I_DN = 44 * 32;
        constexpr int NITEMS = I_IN + 3 * I_SQ + I_GU + I_DN;
        for (int it = gw; it < NITEMS; it += NGW) {
            int r = it;
            if (r < I_IN) { const int kb = r >> 8, nb = r & 255; transpose_item(w_in, INW, WIN, DM, 64 * kb, 32 * nb, map_in(32 * nb), nullptr, scr, lane); continue; } r -= I_IN;
            if (r < I_SQ) { const int kb = r >> 5, nb = r & 31; transpose_item(w_a, DM, WAC, DM, 64 * kb, 32 * nb, 32 * nb, nullptr, scr, lane); continue; } r -= I_SQ;
            if (r < I_SQ) { const int kb = r >> 5, nb = r & 31; transpose_item(w_c, DM, WAC, DM, 64 * kb, 32 * nb, 1024 + 32 * nb, nullptr, scr, lane); continue; } r -= I_SQ;
            if (r < I_SQ) { const int kb = r >> 5, nb = r & 31; transpose_item(w_out, DM, WOUT, DM, 64 * kb, 32 * nb, 32 * nb, nullptr, scr, lane); continue; } r -= I_SQ;
            if (r < I_GU) { const int kb = r / 176, nb = r % 176; transpose_item(w_gu, 2 * DFF, WGU, DM, 64 * kb, 32 * nb, map_gu(32 * nb), g_ffn, scr, lane); continue; } r -= I_GU;
            { const int kb = r >> 5, nb = r & 31; transpose_item(w_dn, DM, WDN, DFF, 64 * kb, 32 * nb, 32 * nb, nullptr, scr, lane); }
        }
        for (int m = gw; m < MTOK; m += 2 * NGW) {
            const int m2 = m + NGW;
            const bool two = m2 < MTOK;
            const f32x4* xr = (const f32x4*)(x + (size_t)m * DM) + lane; const f32x4* xr2 = (const f32x4*)(x + (size_t)(two ? m2 : m) * DM) + lane; const f32x4* gr = (const f32x4*)g_mix + lane;
            f32x4 v[4], w[4]; float s = 0.f, s2 = 0.f;
#pragma unroll
            for (int j = 0; j < 4; ++j) { v[j] = xr[64 * j]; w[j] = xr2[64 * j]; }
#pragma unroll
            for (int j = 0; j < 4; ++j) { s += (v[j].x * v[j].x + v[j].y * v[j].y) + (v[j].z * v[j].z + v[j].w * v[j].w); s2 += (w[j].x * w[j].x + w[j].y * w[j].y) + (w[j].z * w[j].z + w[j].w * w[j].w); }
            const float rstd = 1.0f / sqrtf(wave_sum(s) * (1.0f / DM) + EPS), rstd2 = 1.0f / sqrtf(wave_sum(s2) * (1.0f / DM) + EPS);
            u32x2* o8 = (u32x2*)(U + (size_t)m * DM) + lane; u32x2* o82 = (u32x2*)(U + (size_t)m2 * DM) + lane;
#pragma unroll
            for (int j = 0; j < 4; ++j) { const f32x4 gg = gr[64 * j]; u32x2 a; a.x = cvt_pk_bf16(v[j].x * rstd * gg.x, v[j].y * rstd * gg.y); a.y = cvt_pk_bf16(v[j].z * rstd * gg.z, v[j].w * rstd * gg.w); o8[64 * j] = a;
                if (two) { u32x2 b; b.x = cvt_pk_bf16(w[j].x * rstd2 * gg.x, w[j].y * rstd2 * gg.y); b.y = cvt_pk_bf16(w[j].z * rstd2 * gg.z, w[j].w * rstd2 * gg.w); o82[64 * j] = b; } }
        }
        for (int idx = (vcu * NTHREADS + tid); idx < SEQ * 16; idx += G * NTHREADS) {
            const int pos = idx >> 4, i = idx & 15;
            const double f = exp2(-(double)i * (18.931568569324174 / 16.0));
            const double a = (double)pos * f;
            ROPEC[idx] = (float)cos(a); ROPES[idx] = (float)sin(a);
        }
        PH_END(0);
    }
    GRID_BAR();

    {
        PH_BEGIN(1);
        unsigned char* ws = OPQ(args.ws); unsigned char* outb = (unsigned char*)OPQ(args.out);
        float* ROPEC = WSP(float, WS_ROPE);
        pg8::Gemm g{WSP(bf16_t, WS_U), WSP(bf16_t, WS_U), 1 << 30, WSP(bf16_t, WS_WIN), MTOK, INW, DM}; pg8::StaticOrder S; S.init(MTOK, INW, G, bx);
        pg8::EpiIn E{(bf16_t*)outb, (bf16_t*)(outb + 32 * MiB), WSP(bf16_t, WS_V), WSP(bf16_t, WS_P), WSP(bf16_t, WS_BG), WSP(bf16_t, WS_SGA), WSP(bf16_t, WS_SGC), WSP(float, WS_KM), ROPEC, ROPEC + SEQ * 16};
        pg8::gemm_phase<pg8::EpiIn, pg8::StaticOrder, true, true>(ldsl, g, S, E);
        PH_END(1);
    }
    GRID_BAR();

    {
        PH_BEGIN(2);
        TIDS();
        unsigned char* ws = OPQ(args.ws); unsigned char* outb = (unsigned char*)OPQ(args.out); const float* conv_w = OPQ(args.in[3]);
        bf16_t* PB = WSP(bf16_t, WS_P); bf16_t* BG = WSP(bf16_t, WS_BG); bf16_t* CZ = WSP(bf16_t, WS_U);
        bf16_t* QB_ = (bf16_t*)outb; bf16_t* KB_ = (bf16_t*)(outb + 32 * MiB); bf16_t* VB_ = WSP(bf16_t, WS_V); float* KM = WSP(float, WS_KM);
        for (int w = vcu * NTHREADS + tid; w < 128 * (MTOK / 16); w += G * NTHREADS) {
            const int cgp = w & 127, rc = w >> 7, c0 = cgp * 8, row0 = rc * 16;
            f32x4 w0a = *(const f32x4*)(conv_w + c0), w0b = *(const f32x4*)(conv_w + c0 + 4);
            f32x4 w1a = *(const f32x4*)(conv_w + DM + c0), w1b = *(const f32x4*)(conv_w + DM + c0 + 4);
            f32x4 w2a = *(const f32x4*)(conv_w + 2 * DM + c0), w2b = *(const f32x4*)(conv_w + 2 * DM + c0 + 4);
            f32x4 m2a = {0.f, 0.f, 0.f, 0.f}, m2b = m2a, m1a = m2a, m1b = m2a;
            if ((row0 & (SEQ - 1)) != 0) { unpack8(*(const u32x4*)(PB + (size_t)(row0 - 2) * DM + c0), m2a, m2b); unpack8(*(const u32x4*)(PB + (size_t)(row0 - 1) * DM + c0), m1a, m1b); }
#pragma unroll 4
            for (int r = 0; r < 16; ++r) { const size_t o = (size_t)(row0 + r) * DM + c0;
                f32x4 pa, pb, ba, bb; unpack8(*(const u32x4*)(PB + o), pa, pb); unpack8(*(const u32x4*)(BG + o), ba, bb);
                const f32x4 ya = ba * (w0a * m2a + w1a * m1a + w2a * pa), yb = bb * (w0b * m2b + w1b * m1b + w2b * pb);
                *(u32x4*)(CZ + o) = pack8u(ya, yb);
                m2a = m1a; m2b = m1b; m1a = pa; m1b = pb; }
        }
        for (int item = vcu; item < 256; item += G) {
            const int bh = item >> 4, sq = item & 15, b = bh >> 3, h = bh & 7; const size_t base = (size_t)b * SEQ * DM + h * HD;
#pragma unroll 1
            for (int pass = 0; pass < 2; ++pass)
                att::gate_lists(QB_ + base, KM + (size_t)bh * NKB * HD, pass ? 31 - sq : sq, WSP(unsigned, WS_CNT) + bh * 32, WSP(unsigned short, WS_LIST) + (size_t)bh * LIST_PER_BH);
        }
#if DBG_ATTN
        { const u32x4* src = (const u32x4*)QB_; u32x4* dst = (u32x4*)WSP(bf16_t, WS_SGA);
          for (size_t i = (size_t)vcu * NTHREADS + tid; i < (size_t)MTOK * DM / 8; i += (size_t)G * NTHREADS) dst[i] = src[i]; }
#endif
        PH_END(2);
    }
    GRID_BAR();

    {
        PH_BEGIN(8);
        TIDS();
        unsigned char* ws = OPQ(args.ws); unsigned char* outb = (unsigned char*)OPQ(args.out);
        bf16_t* QB_ = (bf16_t*)outb; bf16_t* KB_ = (bf16_t*)(outb + 32 * MiB); bf16_t* VB_ = WSP(bf16_t, WS_V);
        LAS unsigned* c_l = (LAS unsigned*)(ldsl + att::LDS_STAGE); LAS unsigned* pre_l = c_l + 512;
        if (tid < 512) c_l[tid] = __hip_atomic_load(WSP(unsigned, WS_CNT) + tid, __ATOMIC_RELAXED, __HIP_MEMORY_SCOPE_AGENT);
        __syncthreads();
        if (wave == 0) {
            unsigned v[8], sum = 0u;
#pragma unroll
            for (int i = 0; i < 8; ++i) { v[i] = (c_l[8 * lane + i] + 255u) >> 8; sum += v[i]; }
            unsigned inc = sum;
#pragma unroll
            for (int o = 1; o < 64; o <<= 1) { const unsigned t = __shfl_up(inc, o); if (lane >= o) inc += t; }
            unsigned run = inc - sum;
#pragma unroll
            for (int i = 0; i < 8; ++i) { pre_l[8 * lane + i] = run; run += v[i]; }
            if (lane == 63) pre_l[512] = inc;
        }
        __syncthreads();
        const int T = (int)pre_l[512];
        if (vcu < T) {
            auto mkitem = [&](int k) { int lo = 0, hi = 512;
                while (hi - lo > 1) { const int mid = (lo + hi) >> 1; if ((int)pre_l[mid] <= k) lo = mid; else hi = mid; }
                const int e = __builtin_amdgcn_readfirstlane(lo), c = k - (int)pre_l[e], bh = e >> 5, n = e & 31, b = bh >> 3, h = bh & 7, left = (int)c_l[e] - 256 * c;
                att::BlockRef r; const size_t base = (size_t)b * SEQ * DM + h * HD;
                r.Qb = QB_ + base; r.K = KB_ + base + (size_t)n * 256 * DM; r.V = VB_ + base + (size_t)n * 256 * DM;
                r.list = WSP(unsigned short, WS_LIST) + (size_t)bh * LIST_PER_BH + att::list_off(n) + 256 * c; r.nrows = __builtin_amdgcn_readfirstlane(left < 256 ? left : 256); r.qb = 0; r.O = nullptr;
                const unsigned hb = (unsigned)(h * HD * 2), bo = (unsigned)b * (unsigned)(SEQ * DM * 2);
                r.po0 = (unsigned)WS_PO0 + bo + hb; r.po2 = (b ? (unsigned)WS_PO2B : (unsigned)WS_PO2A) + hb;
                r.lo0 = (unsigned)WS_LSE + (unsigned)(bh * SEQ * 4); return r; };
            att::Seam S; att::BlockRef cur = mkitem(vcu);
            att::attn_prime<0>(cur, (char*)lds, S);
            for (int k = vcu; k < T; k += G) {
                const att::BlockRef nxt = (k + G < T) ? mkitem(k + G) : cur;
                att::attn_block<0>(cur, nxt, (char*)lds, S, ws);
                cur = nxt;
            }
        }
        PH_END(8);
    }
    GRID_BAR();

    {
        PH_BEGIN(9);
        unsigned char* ws = OPQ(args.ws); unsigned char* outb = (unsigned char*)OPQ(args.out);
        bf16_t* QB_ = (bf16_t*)outb; bf16_t* KB_ = (bf16_t*)(outb + 32 * MiB); bf16_t* VB_ = WSP(bf16_t, WS_V);
        if (vcu < 256) {
            const int nblocks = 2 * ((256 - vcu + G - 1) / G);
            auto mkref = [&](int k) { const int item = vcu + (k >> 1) * G, bh = item >> 4, sq = item & 15, b = bh >> 3, h = bh & 7;
                att::BlockRef r; const size_t base = (size_t)b * SEQ * DM + h * HD; r.qb = (k & 1) ? 31 - sq : sq;
                r.Qb = QB_ + base; r.K = KB_ + base + (size_t)r.qb * 256 * DM; r.V = VB_ + base + (size_t)r.qb * 256 * DM; r.O = QB_ + base; r.list = nullptr; r.nrows = 256;
                const unsigned hb = (unsigned)(h * HD * 2), bo = (unsigned)b * (unsigned)(SEQ * DM * 2);
                r.po0 = (unsigned)WS_PO0 + bo + hb; r.po2 = (b ? (unsigned)WS_PO2B : (unsigned)WS_PO2A) + hb;
                r.lo0 = (unsigned)WS_LSE + (unsigned)(bh * SEQ * 4); return r; };
            att::Seam S; att::BlockRef cur = mkref(0);
            att::attn_prime<1>(cur, (char*)lds, S);
            for (int k = 0; k < nblocks; ++k) {
                const att::BlockRef nxt = (k + 1 < nblocks) ? mkref(k + 1) : cur;
                att::attn_block<1>(cur, nxt, (char*)lds, S, ws);
                cur = nxt;
            }
        }
        PH_END(9);
    }
    GRID_BAR();

#if DBG_ATTN
    {
        TIDS();
        unsigned char* ws = OPQ(args.ws); unsigned char* outb = (unsigned char*)OPQ(args.out); float* out = OPQ(args.out);
        unsigned* dbgmax = (unsigned*)(ws + 65536);
        dbg_check(WSP(bf16_t, WS_SGA), (const bf16_t*)(outb + 32 * MiB), WSP(bf16_t, WS_V), (const bf16_t*)outb, WSP(float, WS_KM), dbgmax, ldsl, vcu * 8 + wave, G * 8, lane, wave);
        GRID_BAR();
        const float e = __uint_as_float(__hip_atomic_load(dbgmax, __ATOMIC_RELAXED, __HIP_MEMORY_SCOPE_AGENT));
        GRID_BAR();
        for (size_t i = (size_t)vcu * NTHREADS + tid; i < (size_t)MTOK * DM / 4; i += (size_t)G * NTHREADS) ((f32x4*)out)[i] = (f32x4){0.f, 0.f, 0.f, 0.f};
        GRID_BAR();
        if (bx == 0 && tid == 0) out[0] = 1.0e4f * e;
        return;
    }
#endif
    {
        PH_BEGIN(3);
        unsigned char* ws = OPQ(args.ws); unsigned char* outb = (unsigned char*)OPQ(args.out);
        pg8::Gemm g{(bf16_t*)outb, WSP(bf16_t, WS_U), 64, WSP(bf16_t, WS_WAC), 2 * MTOK, 2 * DM, DM}; pg8::BranchOrder S; S.s.init(MTOK, DM, G, bx);
        pg8::EpiBranch E{WSP(bf16_t, WS_SGA), WSP(bf16_t, WS_SGC), WSP(float, WS_T), WSP(bf16_t, WS_MG)};
        pg8::gemm_phase<pg8::EpiBranch, pg8::BranchOrder, true, true>(ldsl, g, S, E);
        PH_END(3);
    }
    GRID_BAR();

    {
        PH_BEGIN(4);
        unsigned char* ws = OPQ(args.ws);
        pg8::Gemm g{WSP(bf16_t, WS_MG), WSP(bf16_t, WS_MG), 1 << 30, WSP(bf16_t, WS_WOUT), MTOK, DM, DM}; pg8::StaticOrder S; S.init(MTOK, DM, G, bx);
        pg8::EpiH1 E{OPQ(args.in[0]), OPQ(args.out), WSP(bf16_t, WS_H1B), WSP(float, WS_SSQ1)};
        pg8::gemm_phase<pg8::EpiH1, pg8::StaticOrder, true, true>(ldsl, g, S, E);
        PH_END(4);
    }
    GRID_BAR();

    {
        PH_BEGIN(5);
        unsigned char* ws = OPQ(args.ws);
        pg8::Gemm g{WSP(bf16_t, WS_H1B), WSP(bf16_t, WS_H1B), 1 << 30, WSP(bf16_t, WS_WGU), MTOK, 2 * DFF, DM}; pg8::StaticOrder S; S.init(MTOK, 2 * DFF, G, bx);
        pg8::EpiSwiglu E{WSP(float, WS_SSQ1), WSP(bf16_t, WS_HFF)};
        pg8::gemm_phase<pg8::EpiSwiglu, pg8::StaticOrder, true, true>(ldsl, g, S, E);
        PH_END(5);
    }
    GRID_BAR();

    {
        PH_BEGIN(6);
        unsigned char* ws = OPQ(args.ws);
        pg8::Gemm g{WSP(bf16_t, WS_HFF), WSP(bf16_t, WS_HFF), 1 << 30, WSP(bf16_t, WS_WDN), MTOK, DM, DFF}; pg8::StaticOrder S; S.init(MTOK, DM, G, bx);
        pg8::EpiDown E{OPQ(args.out), WSP(float, WS_SSQ2)};
        pg8::gemm_phase<pg8::EpiDown, pg8::StaticOrder, true, true>(ldsl, g, S, E);
        PH_END(6);
    }
    GRID_BAR();

    {
        PH_BEGIN(7);
        TIDS();
        unsigned char* ws = OPQ(args.ws); float* out = OPQ(args.out); const float* g_final = OPQ(args.in[10]); const float* SSQ2 = WSP(float, WS_SSQ2);
        const int gw = vcu * 8 + wave, NGW = G * 8;
        for (int m = gw; m < MTOK; m += NGW) {
            f32x4* xr = (f32x4*)(out + (size_t)m * DM) + lane; const f32x4* gr = (const f32x4*)g_final + lane;
            const float rstd = 1.0f / sqrtf(SSQ2[m] * (1.0f / DM) + EPS);
#pragma unroll
            for (int j = 0; j < 4; ++j) { const f32x4 v = xr[64 * j], gg = gr[64 * j]; xr[64 * j] = v * rstd * gg; }
        }
        PH_END(7);
    }
}

extern "C" void kernel_launch(void* const* d_in, const int* in_sizes, int n_in, void* d_out, int out_size, void* d_ws, size_t ws_size, hipStream_t stream) {
    static int grid = 0;
    if (grid == 0) {
        if (n_in != 11 || out_size != MTOK * DM || ws_size < WS_END) { fprintf(stderr, "kernel_launch: unexpected shapes (n_in %d out %d ws %zu)\n", n_in, out_size, ws_size); grid = -1; return; }
        int dev = 0, cus = 0, per_cu = 0;
        (void)hipGetDevice(&dev); (void)hipDeviceGetAttribute(&cus, hipDeviceAttributeMultiprocessorCount, dev);
        if (hipFuncSetAttribute((const void*)mk_fwd, hipFuncAttributeMaxDynamicSharedMemorySize, LDS_BYTES) != hipSuccess) { fprintf(stderr, "kernel_launch: hipFuncSetAttribute failed\n"); grid = -1; return; }
        if (hipOccupancyMaxActiveBlocksPerMultiprocessor(&per_cu, (const void*)mk_fwd, NTHREADS, LDS_BYTES) != hipSuccess || per_cu < 1) { fprintf(stderr, "kernel_launch: occupancy query failed (%d)\n", per_cu); grid = -1; return; }
        grid = cus * per_cu;
        if (grid > 256) grid = 256;
        grid &= ~7;
        fprintf(stderr, "kernel_launch: cus %d per_cu %d grid %d\n", cus, per_cu, grid);
    }
    if (grid <= 0) return;
    (void)hipMemsetAsync((char*)d_ws + WS_CTL, 0, CTL_ZERO_BYTES, stream);
    Args a{};
    for (int i = 0; i < 11; ++i) a.in[i] = (const float*)d_in[i];
    a.out = (float*)d_out; a.ws = (unsigned char*)d_ws; a.use_cg = 0; a.pad = 0;
    void* kargs[] = {&a};
    hipError_t e = hipLaunchCooperativeKernel((const void*)mk_fwd, dim3(grid), dim3(NTHREADS), kargs, LDS_BYTES, stream);
    if (e != hipSuccess) fprintf(stderr, "kernel_launch: cooperative launch failed: %s (grid %d)\n", hipGetErrorString(e), grid);
}
```
